# Optimizing an MI355X kernel written in HIP

```python
import jax
import jax.numpy as jnp
from jax import lax
import numpy as np

D_MODEL = 1024
BATCH = 2
SEQ = 8192
DEPTH = 2

PLE_DIM = 256
POOL_WINDOWS = (2, 4, 8, 16)
N_POOL_GROUPS = len(POOL_WINDOWS)
POOL_GROUP = D_MODEL // 8
POOL_WIDTH = N_POOL_GROUPS * POOL_GROUP
N_HEADS = 8
Q_LORA = D_MODEL // 2
KV_LORA = D_MODEL // 4
QK_NOPE = 128
QK_ROPE = 64
QK_HEAD = QK_NOPE + QK_ROPE
V_HEAD = 128
ATTN_WIDTH = N_HEADS * V_HEAD
D_FF = -(-8 * D_MODEL // (3 * 256)) * 256
ROPE_THETA = 10000.0
EPS = 1e-6
Q_BLOCK = 128

_OFF_Q = POOL_WIDTH
_OFF_KV = _OFF_Q + Q_LORA
_OFF_KR = _OFF_KV + KV_LORA
_OFF_GA = _OFF_KR + QK_ROPE
_OFF_GB = _OFF_GA + D_MODEL
IN_WIDTH = _OFF_GB + D_MODEL

kernel_name = 'hybrid_pool_mla_gated_block'


def rms_norm(x, g):
    xf = x.astype(jnp.float32)
    y = xf * lax.rsqrt(jnp.mean(xf * xf, axis=-1, keepdims=True) + EPS)
    return (y * g.astype(jnp.float32)).astype(x.dtype)


def rope_tables(positions):
    inv_freq = 1.0 / (ROPE_THETA ** (jnp.arange(0, QK_ROPE, 2, dtype=jnp.float32) / QK_ROPE))
    ang = positions.astype(jnp.float32)[..., None] * inv_freq
    return jnp.cos(ang)[:, :, None, :], jnp.sin(ang)[:, :, None, :]


def apply_rope(x, cos, sin):
    xf = x.astype(jnp.float32)
    half = QK_ROPE // 2
    x1, x2 = xf[..., :half], xf[..., half:]
    return jnp.concatenate([x1 * cos - x2 * sin, x2 * cos + x1 * sin], axis=-1).astype(x.dtype)


def multiscale_pool(u, w_pool, pool_scale):
    B, S, _ = u.shape
    uf = u.astype(jnp.float32).reshape(B, S, N_POOL_GROUPS, POOL_GROUP)
    csum = jnp.concatenate([jnp.zeros((B, 1, N_POOL_GROUPS, POOL_GROUP), jnp.float32),
                            jnp.cumsum(uf, axis=1)], axis=1)
    t = jnp.arange(S)
    pooled = []
    for g, w in enumerate(POOL_WINDOWS):
        hi = csum[:, 1:, g]
        lo = jnp.concatenate([jnp.zeros((B, w - 1, POOL_GROUP), jnp.float32),
                              csum[:, :S - w + 1, g]], axis=1)
        cnt = jnp.minimum(t + 1, w).astype(jnp.float32)[None, :, None]
        pooled.append((hi - lo) / cnt - uf[:, :, g])
    pooled = jnp.stack(pooled, axis=2).astype(u.dtype)
    mixed = jnp.einsum('bsgc,gcd->bsgd', pooled, w_pool)
    return mixed.reshape(B, S, POOL_WIDTH) * pool_scale


def causal_block_attention(q, k, v):
    B, S, H, Dq = q.shape
    nb = S // Q_BLOCK
    scale = QK_HEAD ** -0.5
    q_blocks = q.reshape(B, nb, Q_BLOCK, H, Dq).transpose(1, 0, 2, 3, 4)
    key_idx = jnp.arange(S)
    neg = jnp.finfo(jnp.float32).min

    def one_block(args):
        qb, bi = args
        s = jnp.einsum('bqhd,bkhd->bhqk', qb, k, preferred_element_type=jnp.float32) * scale
        q_idx = bi * Q_BLOCK + jnp.arange(Q_BLOCK)
        mask = key_idx[None, :] <= q_idx[:, None]
        s = jnp.where(mask[None, None], s, neg)
        pr = jax.nn.softmax(s, axis=-1)
        return jnp.einsum('bhqk,bkhd->bqhd', pr.astype(v.dtype), v)

    out = lax.map(one_block, (q_blocks, jnp.arange(nb)))
    return out.transpose(1, 0, 2, 3, 4).reshape(B, S, H * v.shape[-1])


def mla(c_q, c_kv, k_rope, q_norm_g, kv_norm_g, w_uq, w_ukv, cos, sin):
    B, S, _ = c_q.shape
    q = jnp.einsum('bsr,rhd->bshd', rms_norm(c_q, q_norm_g), w_uq)
    q = jnp.concatenate([q[..., :QK_NOPE], apply_rope(q[..., QK_NOPE:], cos, sin)], axis=-1)
    kv = jnp.einsum('bsr,rhd->bshd', rms_norm(c_kv, kv_norm_g), w_ukv)
    k_nope, v = kv[..., :QK_NOPE], kv[..., QK_NOPE:]
    k_pe = apply_rope(k_rope[:, :, None, :], cos, sin)
    k = jnp.concatenate([k_nope, jnp.broadcast_to(k_pe, (B, S, N_HEADS, QK_ROPE))], axis=-1)
    return causal_block_attention(q, k, v)


def setup_inputs(seed: int = 0) -> dict:
    key = jax.random.key(seed)
    ks = jax.random.split(key, 24)
    f32 = jnp.float32

    def dense(k, shape, fan_in):
        return jax.random.normal(k, shape, f32) * fan_in ** -0.5

    def gain(k, shape, s=0.05):
        return 1.0 + s * jax.random.normal(k, shape, f32)

    L = DEPTH
    return {
        'x': jax.random.normal(ks[0], (BATCH, SEQ, D_MODEL), f32),
        'p': jax.random.normal(ks[1], (L, BATCH, SEQ, PLE_DIM), f32),
        'positions': jnp.tile(jnp.arange(SEQ, dtype=jnp.int32)[None, :], (BATCH, 1)),
        'norm_mix': gain(ks[2], (L, D_MODEL)),
        'w_in': dense(ks[3], (L, D_MODEL, IN_WIDTH), D_MODEL),
        'w_pool': dense(ks[4], (L, N_POOL_GROUPS, POOL_GROUP, POOL_GROUP), POOL_GROUP),
        'pool_scale': gain(ks[5], (L, POOL_WIDTH), 0.1),
        'q_norm': gain(ks[6], (L, Q_LORA)),
        'kv_norm': gain(ks[7], (L, KV_LORA)),
        'w_uq': dense(ks[8], (L, Q_LORA, N_HEADS, QK_HEAD), Q_LORA),
        'w_ukv': dense(ks[9], (L, KV_LORA, N_HEADS, QK_NOPE + V_HEAD), KV_LORA),
        'w_a': dense(ks[10], (L, POOL_WIDTH, D_MODEL), POOL_WIDTH),
        'w_b': dense(ks[11], (L, ATTN_WIDTH, D_MODEL), ATTN_WIDTH),
        'w_o': dense(ks[12], (L, D_MODEL, D_MODEL), D_MODEL),
        'norm_ffn': gain(ks[13], (L, D_MODEL)),
        'w_gate': dense(ks[14], (L, D_MODEL, D_FF), D_MODEL),
        'w_up': dense(ks[15], (L, D_MODEL, D_FF), D_MODEL),
        'w_down': dense(ks[16], (L, D_FF, D_MODEL), D_FF),
        'norm_ple': gain(ks[17], (L, D_MODEL)),
        'w_ple_gate': dense(ks[18], (L, D_MODEL, D_MODEL), D_MODEL),
        'w_ple': dense(ks[19], (L, PLE_DIM, D_MODEL), PLE_DIM),
        'final_norm': gain(ks[20], (D_MODEL,)),
    }


def reference(x, p, positions, norm_mix, w_in, w_pool, pool_scale, q_norm, kv_norm, w_uq, w_ukv,
              w_a, w_b, w_o, norm_ffn, w_gate, w_up, w_down, norm_ple, w_ple_gate, w_ple,
              final_norm):
    cos, sin = rope_tables(positions)
    for i in range(DEPTH):
        h = rms_norm(x, norm_mix[i])
        z = h @ w_in[i]
        u = z[..., :_OFF_Q]
        c_q = z[..., _OFF_Q:_OFF_KV]
        c_kv = z[..., _OFF_KV:_OFF_KR]
        k_rope = z[..., _OFF_KR:_OFF_GA]
        gate_a = z[..., _OFF_GA:_OFF_GB]
        gate_b = z[..., _OFF_GB:]
        y_a = multiscale_pool(u, w_pool[i], pool_scale[i]) @ w_a[i]
        y_b = mla(c_q, c_kv, k_rope, q_norm[i], kv_norm[i], w_uq[i], w_ukv[i], cos, sin) @ w_b[i]
        merged = jax.nn.sigmoid(gate_a) * y_a + jax.nn.sigmoid(gate_b) * y_b
        x = x + merged @ w_o[i]
        h = rms_norm(x, norm_ffn[i])
        x = x + (jax.nn.silu(h @ w_gate[i]) * (h @ w_up[i])) @ w_down[i]
        g = jax.nn.sigmoid(rms_norm(x, norm_ple[i]) @ w_ple_gate[i])
        x = x + g * (p[i] @ w_ple[i])
    return rms_norm(x, final_norm)
```

```cpp
#include <hip/hip_runtime.h>
#include <hip/hip_cooperative_groups.h>
#include <cstdio>
#include <cstdint>
#include <cmath>
namespace cg = cooperative_groups;
namespace pg8 {
#define PG8_LAS __attribute__((address_space(3)))
typedef unsigned short bf16_t;
typedef short bf16x8 __attribute__((ext_vector_type(8)));
typedef float f32x4 __attribute__((ext_vector_type(4)));
typedef unsigned u32x4 __attribute__((ext_vector_type(4)));
constexpr int BM = 256, BK = 64, HALF = 128, HTB = HALF * BK * 2  , STAGE_BYTES = 8 * HTB, NXCD = 8, WGM = 8;

__host__ __device__ __forceinline__ int lds_byte(int r, int c) { const int st = (r >> 4) * 2 + (c >> 5), rr = r & 15, cc = c & 31, ob = rr * 64 + cc * 2; return st * 1024 + (ob ^ (((ob >> 9) & 1) << 5)); }
__host__ __device__ __forceinline__ void stage_rc(int b, int& R, int& C) { const int st = b / 1024, sb = b % 1024, swz = sb ^ (((sb >> 9) & 1) << 5); R = (st >> 1) * 16 + swz / 64; C = (st & 1) * 32 + (swz % 64) / 2; }
__host__ __device__ __forceinline__ int perm32(int rho) { const int n = rho >> 4, i = rho & 15; return 8 * (i >> 2) + 4 * n + (i & 3); }

struct Unit { int pm, pn; };
struct Gemm { const bf16_t* A; const bf16_t* Bt; int M, N, K; };

struct StaticOrder {
    int nM, nN, nwg, G, c;
    __host__ __device__ void init(int M, int N, int G_, int c_) { nM = M / BM; nN = N / BM; nwg = nM * nN; G = G_; c = c_; }
    __host__ __device__ bool next(int i, Unit& u) const {
        const long L = (long)i * G + c; if (L >= nwg) return false;
        int wgid = (int)L; { const int q = nwg / NXCD, r = nwg % NXCD, xcd = wgid % NXCD, off = wgid / NXCD; wgid = (xcd < r ? xcd * (q + 1) : r * (q + 1) + (xcd - r) * q) + off; }
        const int nig = WGM * nN, gid = wgid / nig, fm = gid * WGM, gsz = (nM - fm) < WGM ? (nM - fm) : WGM;
        u.pm = fm + ((wgid % nig) % gsz); u.pn = (wgid % nig) / gsz; return true;
    }
    __device__ __forceinline__ void a_ready(const Unit&) const {}
    __device__ __forceinline__ void done(const Unit&) const {}
};

__device__ __forceinline__ unsigned cvt_pk_bf16(float lo, float hi) { unsigned r; asm volatile("v_cvt_pk_bf16_f32 %0, %1, %2" : "=v"(r) : "v"(lo), "v"(hi)); return r; }
template <class Epi, class Sched, bool ALIGN_EPI = false, bool SP2 = false>
__device__ __forceinline__ void gemm_phase(PG8_LAS unsigned char* lds, const Gemm g, const Sched& S, const Epi& E) {
    int tid_ = threadIdx.x; asm volatile("" : "+v"(tid_)); const int tid = tid_, wid = __builtin_amdgcn_readfirstlane(tid >> 6), lane = tid & 63, wr = wid >> 2, wc = wid & 3, fr = lane & 15, fq = lane >> 4;
    const int K = g.K, nt = K / BK;
    unsigned voffA[2], voffB[2];
#pragma unroll
    for (int i = 0; i < 2; ++i) { int R, C; stage_rc(tid * 16 + i * 8192, R, C); const int Rb = Epi::PERM ? ((R & ~31) + perm32(R & 31)) : R;
        voffA[i] = (unsigned)(R * K + C) * 2u; voffB[i] = (unsigned)(Rb * K + C) * 2u; }
    const size_t kstep = (size_t)(BK * 2);
    const size_t hstep = (size_t)HALF * K * 2;
    const size_t tstep = 2 * hstep;
    const unsigned ldsw = (unsigned)wid * 1024u;
    const int aoff = lds_byte(wr * 64 + fr, fq * 8), boff = lds_byte(wc * 32 + fr, fq * 8);
#define PG8_SA(b, h) (((b) * 2 + (h)) * HTB)
#define PG8_SB(b, h) ((4 + (b) * 2 + (h)) * HTB)
#define PG8_STAGE(bufoff, gbase, voff) do { _Pragma("unroll") for (int _i = 0; _i < 2; ++_i) \
        __builtin_amdgcn_global_load_lds((const unsigned*)((const char*)(gbase) + (voff)[_i]), (PG8_LAS unsigned*)(lds + (bufoff) + ldsw + _i * 8192), 16, 0, 0); } while (0)
#define PG8_LDA(dst, b, h) do { _Pragma("unroll") for (int m = 0; m < 4; ++m) _Pragma("unroll") for (int k = 0; k < 2; ++k) dst[m][k] = *(const PG8_LAS bf16x8*)(lds + PG8_SA(b, h) + aoff + m * 2048 + k * 1024); } while (0)
#define PG8_LDB(dst, b, h) do { _Pragma("unroll") for (int n = 0; n < 2; ++n) _Pragma("unroll") for (int k = 0; k < 2; ++k) dst[n][k] = *(const PG8_LAS bf16x8*)(lds + PG8_SB(b, h) + boff + n * 2048 + k * 1024); } while (0)
#define PG8_MMA(ai, bj, At, Bt) do { __builtin_amdgcn_s_setprio(1); _Pragma("unroll") for (int m = 0; m < 4; ++m) _Pragma("unroll") for (int n = 0; n < 2; ++n) _Pragma("unroll") for (int k = 0; k < 2; ++k) \
        acc[ai][bj][m][n] = __builtin_amdgcn_mfma_f32_16x16x32_bf16(Bt[n][k], At[m][k], acc[ai][bj][m][n], 0, 0, 0); __builtin_amdgcn_s_setprio(0); } while (0)
#define PG8_WAIT_V(n) asm volatile("s_waitcnt vmcnt(" #n ")" ::: "memory")
#define PG8_WAIT_L(n) asm volatile("s_waitcnt lgkmcnt(" #n ")" ::: "memory")
#define PG8_BAR __builtin_amdgcn_s_barrier()
#define PG8_SCHED __builtin_amdgcn_sched_barrier(0)
    Unit cur, nxt; int ui = 0;
    if (!S.next(0, cur)) return;
    f32x4 acc[2][2][4][2];
#pragma unroll
    for (int a = 0; a < 2; ++a)
#pragma unroll
        for (int b = 0; b < 2; ++b)
#pragma unroll
            for (int m = 0; m < 4; ++m)
#pragma unroll
                for (int n = 0; n < 2; ++n) acc[a][b][m][n] = (f32x4){0.f, 0.f, 0.f, 0.f};
    bf16x8 At[4][2], B0[2][2], B1[2][2];
    const char* cA = (const char*)g.A + (size_t)cur.pm * tstep; const char* cB = (const char*)g.Bt + (size_t)cur.pn * tstep;
    S.a_ready(cur);
    if constexpr (SP2) {
        PG8_STAGE(PG8_SB(0, 0), cB, voffB); PG8_STAGE(PG8_SB(0, 1), cB + hstep, voffB); PG8_STAGE(PG8_SA(0, 0), cA, voffA); PG8_STAGE(PG8_SA(0, 1), cA + hstep, voffA);
        if (wr == 1) PG8_BAR;
        PG8_WAIT_V(2); PG8_BAR;
        PG8_STAGE(PG8_SB(1, 0), cB + kstep, voffB); PG8_STAGE(PG8_SA(1, 0), cA + kstep, voffA); PG8_STAGE(PG8_SB(1, 1), cB + hstep + kstep, voffB);
        PG8_WAIT_V(6); PG8_BAR;
    } else {
        PG8_STAGE(PG8_SB(0, 0), cB, voffB); PG8_STAGE(PG8_SA(0, 0), cA, voffA); PG8_STAGE(PG8_SB(0, 1), cB + hstep, voffB); PG8_STAGE(PG8_SA(0, 1), cA + hstep, voffA);
        if (wr == 1) PG8_BAR;
        PG8_WAIT_V(4); PG8_BAR;
        PG8_STAGE(PG8_SB(1, 0), cB + kstep, voffB); PG8_STAGE(PG8_SA(1, 0), cA + kstep, voffA); PG8_STAGE(PG8_SB(1, 1), cB + hstep + kstep, voffB);
        PG8_WAIT_V(6); PG8_BAR;
    }
    for (;;) {
        const bool has_next = S.next(ui + 1, nxt);
        const char* nA = has_next ? (const char*)g.A + (size_t)nxt.pm * tstep : cA; const char* nB = has_next ? (const char*)g.Bt + (size_t)nxt.pn * tstep : cB;
        for (int t = 0; t < nt; t += 2) {
            const bool last = (t == nt - 2);
            const char* a1 = cA + (size_t)(t + 1) * kstep;
            const char* a2 = last ? nA : cA + (size_t)(t + 2) * kstep; const char* b2 = last ? nB : cB + (size_t)(t + 2) * kstep;
            const char* a3 = a2 + kstep; const char* b3 = b2 + kstep;
            if (last && has_next) S.a_ready(nxt);
            if constexpr (SP2) {
            PG8_LDB(B0, 0, 0); PG8_LDB(B1, 0, 1); PG8_SCHED; PG8_LDA(At, 0, 0); PG8_STAGE(PG8_SA(1, 1), a1 + hstep, voffA);
            PG8_WAIT_V(8); PG8_WAIT_L(0); PG8_BAR; PG8_MMA(0, 0, At, B0); PG8_MMA(0, 1, At, B1); PG8_BAR; PG8_SCHED;
            PG8_LDA(At, 0, 1); PG8_STAGE(PG8_SB(0, 0), b2, voffB); PG8_STAGE(PG8_SB(0, 1), b2 + hstep, voffB); PG8_STAGE(PG8_SA(0, 0), a2, voffA);
            PG8_WAIT_V(8); PG8_WAIT_L(0); PG8_BAR; PG8_MMA(1, 0, At, B0); PG8_MMA(1, 1, At, B1); PG8_BAR; PG8_SCHED;
            PG8_LDB(B0, 1, 0); PG8_LDB(B1, 1, 1); PG8_SCHED; PG8_LDA(At, 1, 0); PG8_STAGE(PG8_SA(0, 1), a2 + hstep, voffA);
            PG8_WAIT_V(8); PG8_WAIT_L(0); PG8_BAR; PG8_MMA(0, 0, At, B0); PG8_MMA(0, 1, At, B1); PG8_BAR; PG8_SCHED;
            PG8_LDA(At, 1, 1); PG8_STAGE(PG8_SB(1, 0), b3, voffB); PG8_STAGE(PG8_SB(1, 1), b3 + hstep, voffB); PG8_STAGE(PG8_SA(1, 0), a3, voffA);
            PG8_WAIT_V(8); PG8_WAIT_L(0); PG8_BAR; PG8_MMA(1, 0, At, B0); PG8_MMA(1, 1, At, B1); PG8_BAR; PG8_SCHED;
            } else {
            PG8_LDB(B0, 0, 0); PG8_SCHED; PG8_LDA(At, 0, 0); PG8_STAGE(PG8_SA(1, 1), a1 + hstep, voffA);
            PG8_WAIT_L(8); PG8_BAR; PG8_WAIT_L(0); PG8_MMA(0, 0, At, B0); PG8_BAR; PG8_SCHED;
            PG8_LDB(B1, 0, 1); PG8_STAGE(PG8_SB(0, 0), b2, voffB);
            PG8_BAR; PG8_WAIT_L(0); PG8_MMA(0, 1, At, B1); PG8_BAR;
            PG8_LDA(At, 0, 1); PG8_STAGE(PG8_SA(0, 0), a2, voffA);
            PG8_BAR; PG8_WAIT_L(0); PG8_MMA(1, 0, At, B0); PG8_BAR; PG8_SCHED;
            PG8_STAGE(PG8_SB(0, 1), b2 + hstep, voffB);
            PG8_WAIT_V(6); PG8_BAR; PG8_MMA(1, 1, At, B1); PG8_BAR;
            PG8_LDB(B0, 1, 0); PG8_SCHED; PG8_LDA(At, 1, 0); PG8_STAGE(PG8_SA(0, 1), a2 + hstep, voffA);
            PG8_WAIT_L(8); PG8_BAR; PG8_WAIT_L(0); PG8_MMA(0, 0, At, B0); PG8_BAR; PG8_SCHED;
            PG8_LDB(B1, 1, 1); PG8_STAGE(PG8_SB(1, 0), b3, voffB);
            PG8_BAR; PG8_WAIT_L(0); PG8_MMA(0, 1, At, B1); PG8_BAR;
            PG8_LDA(At, 1, 1); PG8_STAGE(PG8_SA(1, 0), a3, voffA);
            PG8_BAR; PG8_WAIT_L(0); PG8_MMA(1, 0, At, B0); PG8_BAR; PG8_SCHED;
            PG8_STAGE(PG8_SB(1, 1), b3 + hstep, voffB);
            PG8_WAIT_V(6); PG8_BAR; PG8_MMA(1, 1, At, B1); PG8_BAR;
            }
        }
        if constexpr (ALIGN_EPI) { if (wr == 0) PG8_BAR; }
        if constexpr (!Epi::AFTER_DRAIN) { E(acc, cur, wr, wc, fr, fq); S.done(cur); }
        if (!has_next) break;
#pragma unroll
        for (int a = 0; a < 2; ++a)
#pragma unroll
            for (int b = 0; b < 2; ++b)
#pragma unroll
                for (int m = 0; m < 4; ++m)
#pragma unroll
                    for (int n = 0; n < 2; ++n) acc[a][b][m][n] = (f32x4){0.f, 0.f, 0.f, 0.f};
        cur = nxt; cA = nA; cB = nB; ++ui;
        if constexpr (ALIGN_EPI) { if (wr == 1) PG8_BAR; }
    }
    PG8_WAIT_V(0);
    if constexpr (!ALIGN_EPI) { if (wr == 0) PG8_BAR; }
    PG8_BAR;
    if constexpr (Epi::AFTER_DRAIN) { E.fused(acc, cur, wr, wc, fr, fq, lds, wid, lane); S.done(cur); }
#undef PG8_SA
#undef PG8_SB
#undef PG8_STAGE
#undef PG8_LDA
#undef PG8_LDB
#undef PG8_MMA
#undef PG8_WAIT_V
#undef PG8_WAIT_L
#undef PG8_BAR
#undef PG8_SCHED
}
}

#define LAS __attribute__((address_space(3)))
typedef unsigned short bf16_t;
typedef short bf16x8 __attribute__((ext_vector_type(8)));
typedef float f32x4 __attribute__((ext_vector_type(4)));
typedef float f32x16 __attribute__((ext_vector_type(16)));
typedef unsigned u32x4 __attribute__((ext_vector_type(4)));
typedef unsigned u32x2 __attribute__((ext_vector_type(2)));
using pg8::Unit;

constexpr int M = 16384, DM = 1024, SEQ = 8192, NHEAD = 8, DEPTH = 2, DFF = 2816, PLE = 256, INW = 3392;
constexpr float EPS = 1e-6f;
constexpr int NTHREADS = 512;
constexpr int LDS_BYTES = 131072 + 4096;

constexpr size_t MiB = 1u << 20;
constexpr size_t WS_COS = 1 * MiB, WS_SIN = 3 * MiB, WS_PB = 5 * MiB;
constexpr size_t W_IN = 13 * MiB, W_G = 16 * MiB, W_UQ = 20 * MiB, W_UKV = W_UQ + 3 * MiB / 2, W_A = W_UKV + MiB, W_B = W_A + MiB, W_O = W_B + 2 * MiB,
                 W_GU = W_O + 2 * MiB, W_D = W_GU + 11 * MiB, W_PG = W_D + 11 * MiB / 2, W_PLE = W_PG + 2 * MiB;
constexpr size_t ARENA = 47 * MiB;
static_assert(W_PLE + MiB / 2 <= ARENA, "weights fit");
constexpr size_t A_XB0 = ARENA, A_POOL = ARENA + 32 * MiB, A_KPE = ARENA + 48 * MiB, A_U = ARENA + 50 * MiB, A_CQ = ARENA + 66 * MiB, A_CKV = ARENA + 82 * MiB,
                 A_QN = ARENA + 90 * MiB, A_QR = ARENA + 122 * MiB, A_KN = ARENA + 138 * MiB, A_VT = ARENA + 170 * MiB, A_END = ARENA + 202 * MiB;
constexpr size_t A_SGA = ARENA + 50 * MiB, A_SGB = ARENA + 138 * MiB, A_XB1 = ARENA + 90 * MiB, A_HMID = ARENA, A_XB2 = ARENA + 122 * MiB, A_G = ARENA + 154 * MiB;
constexpr size_t WS_SSQ = A_END, WS_BAR = A_END + 3 * MiB, WS_BAR_BYTES = 16384, WS_END = WS_BAR + WS_BAR_BYTES;
static_assert(WS_END <= 256 * MiB, "workspace");
constexpr int ST_X = 0, ST_Q = 1, ST_KV = 2, ST_1 = 1, ST_2 = 2;
__device__ __forceinline__ void st8(void* p, u32x2 v) { *(u32x2*)p = v; }
__device__ __forceinline__ void st16(void* p, u32x4 v) { *(u32x4*)p = v; }
__device__ __forceinline__ void st16f(float* p, f32x4 v) { *(f32x4*)p = v; }
__device__ __forceinline__ u32x2 ld8c(const void* p) { return *(const u32x2*)p; }
__device__ __forceinline__ u32x4 ld16c(const void* p) { return *(const u32x4*)p; }
__device__ __forceinline__ f32x4 ld16cf(const float* p) { return *(const f32x4*)p; }
__device__ __forceinline__ void st4(void* p, unsigned v) { *(unsigned*)p = v; }
__device__ __forceinline__ void st4f(float* p, float v) { *p = v; }
__device__ __forceinline__ void st2(bf16_t* p, unsigned v) { *p = (bf16_t)v; }
__device__ __forceinline__ unsigned pk(float lo, float hi) { return pg8::cvt_pk_bf16(lo, hi); }
__device__ __forceinline__ float bflo(unsigned w) { return __uint_as_float(w << 16); }
__device__ __forceinline__ float bfhi(unsigned w) { return __uint_as_float(w & 0xffff0000u); }
__device__ __forceinline__ float sigm(float x) { return __builtin_amdgcn_rcpf(1.f + __expf(-x)); }
__device__ __forceinline__ u32x4 pack8(f32x4 a, f32x4 b) { u32x4 w; w.x = pk(a[0], a[1]); w.y = pk(a[2], a[3]); w.z = pk(b[0], b[1]); w.w = pk(b[2], b[3]); return w; }
__device__ __forceinline__ f32x4 unlo(u32x4 w) { return (f32x4){bflo(w.x), bfhi(w.x), bflo(w.y), bfhi(w.y)}; }
__device__ __forceinline__ f32x4 unhi(u32x4 w) { return (f32x4){bflo(w.z), bfhi(w.z), bflo(w.w), bfhi(w.w)}; }
__device__ __forceinline__ float sq4(f32x4 a) { return (a[0] * a[0] + a[1] * a[1]) + (a[2] * a[2] + a[3] * a[3]); }
__device__ __forceinline__ float quad_reduce(float s) { s += __shfl_xor(s, 16); s += __shfl_xor(s, 32); return s; }
__device__ __forceinline__ float rstd_of(const float* st, int row, int fq, int nparts, float invk) { const f32x4 v = ld16cf(st + (unsigned)row * 16u + 4u * fq);
    float s = (4 * fq < nparts) ? (v[0] + v[1]) + (v[2] + v[3]) : 0.f; s = quad_reduce(s); return rsqrtf(s * invk + EPS); }

__device__ __forceinline__ unsigned char* fresh(unsigned char* p) { size_t z = 0; asm volatile("" : "+s"(z)); return p + z; }
#define EPI_ROWS(...) _Pragma("unroll") for (int ai = 0; ai < 2; ++ai) _Pragma("unroll") for (int m = 0; m < 4; ++m) { const int row = u.pm * 256 + ai * 128 + wr * 64 + m * 16 + fr; __VA_ARGS__ if (m & 1) asm volatile("" ::: "memory"); }
typedef const f32x4 (&AccRef)[2][2][4][2];

typedef float f32x2 __attribute__((ext_vector_type(2)));
__device__ __forceinline__ void rope_store2(bf16_t* dst, f32x4 v, const float* cosT, const float* sinT, int row, int j0) {
    const unsigned to = (unsigned)row * 32u + (unsigned)j0; const f32x2 cs = *(const f32x2*)(cosT + to), sn = *(const f32x2*)(sinT + to);
    const float a0 = v[0] * cs[0] - v[1] * sn[0], a1 = v[2] * cs[1] - v[3] * sn[1], b0 = v[1] * cs[0] + v[0] * sn[0], b1 = v[3] * cs[1] + v[2] * sn[1];
    st4(dst + j0, pk(a0, a1)); st4(dst + 32 + j0, pk(b0, b1));
}
#define EFENCE() asm volatile("" ::: "memory")
__device__ __forceinline__ void rope_store2v(bf16_t* dst, f32x4 v, float c0, float c1, float s0, float s1, int j0) {
    const float a0 = v[0] * c0 - v[1] * s0, a1 = v[2] * c1 - v[3] * s1, b0 = v[1] * c0 + v[0] * s0, b1 = v[3] * c1 + v[2] * s1;
    st4(dst + j0, pk(a0, a1)); st4(dst + 32 + j0, pk(b0, b1));
}
__device__ __forceinline__ u32x2 ld8_coherent(const bf16_t* p) { const unsigned long long v = __hip_atomic_load((const unsigned long long*)p, __ATOMIC_RELAXED, __HIP_MEMORY_SCOPE_AGENT); u32x2 w; w.x = (unsigned)v; w.y = (unsigned)(v >> 32); return w; }
__device__ __forceinline__ u32x2 pack4(f32x4 a) { u32x2 w; w.x = pk(a[0], a[1]); w.y = pk(a[2], a[3]); return w; }
__device__ __forceinline__ f32x4 un4(u32x2 w) { return (f32x4){bflo(w.x), bfhi(w.x), bflo(w.y), bfhi(w.y)}; }

struct EpiZ { static constexpr bool PERM = true, AFTER_DRAIN = false;
    const float* ssqx; bf16_t *U, *CQ, *CKV, *KPE; float *ssqq, *ssqkv; const float *cosT, *sinT;
    __device__ __forceinline__ void operator()(AccRef acc, const Unit& u, int wr, int wc, int fr, int fq) const {
        const int pn = u.pn, cw = wc * 32 + 8 * fq;
        EPI_ROWS(
            const float r = rstd_of(ssqx, row, fq, 16, 1.f / 1024.f);
            if (pn < 5) {
                bf16_t* dst; float* sq = nullptr;
                if (pn < 2) dst = U + (unsigned)row * 512 + pn * 256; else if (pn < 4) { dst = CQ + (unsigned)row * 512 + (pn - 2) * 256; sq = ssqq + (pn - 2) * 4 + wc; } else { dst = CKV + (unsigned)row * 256; sq = ssqkv + wc; }
                float s = 0.f;
                _Pragma("unroll") for (int bj = 0; bj < 2; ++bj) { const f32x4 v0 = acc[ai][bj][m][0] * r, v1 = acc[ai][bj][m][1] * r; s += sq4(v0) + sq4(v1); st16(dst + bj * 128 + cw, pack8(v0, v1)); }
                if (sq) { s = quad_reduce(s); if (fq == 0) st4f(sq + (unsigned)row * 16u, s); }
            } else if (wc < 2) {
                const int j0 = 16 * wc + 4 * fq; const f32x4 cs = *(const f32x4*)(cosT + (unsigned)row * 32u + j0), sn = *(const f32x4*)(sinT + (unsigned)row * 32u + j0);
                rope_store2v(KPE + (unsigned)row * 64, acc[ai][0][m][0] * r, cs[0], cs[1], sn[0], sn[1], j0); rope_store2v(KPE + (unsigned)row * 64, acc[ai][0][m][1] * r, cs[2], cs[3], sn[2], sn[3], j0 + 2);
            }
        )
    }
};
struct EpiGate { static constexpr bool PERM = true, AFTER_DRAIN = false;
    const float* ssq; float invk; bf16_t* O;
    __device__ __forceinline__ void operator()(AccRef acc, const Unit& u, int wr, int wc, int fr, int fq) const {
        const int cw = u.pn * 256 + wc * 32 + 8 * fq;
        EPI_ROWS(
            const float r = rstd_of(ssq, row, fq, 16, invk);
            _Pragma("unroll") for (int bj = 0; bj < 2; ++bj) { f32x4 v0 = acc[ai][bj][m][0] * r, v1 = acc[ai][bj][m][1] * r;
                _Pragma("unroll") for (int e = 0; e < 4; ++e) { v0[e] = sigm(v0[e]); v1[e] = sigm(v1[e]); }
                st16(O + (unsigned)row * 1024 + bj * 128 + cw, pack8(v0, v1)); }
        )
    }
};
struct EpiQ { static constexpr bool PERM = true, AFTER_DRAIN = false;
    const float* ssqq; bf16_t *QN, *QR; const float *cosT, *sinT;
    __device__ __forceinline__ void operator()(AccRef acc, const Unit& u, int wr, int wc, int fr, int fq) const {
        const int pn = u.pn;
        EPI_ROWS(
            const float r = rstd_of(ssqq, row, fq, 8, 1.f / 512.f);
            if (pn < 4) {
                _Pragma("unroll") for (int bj = 0; bj < 2; ++bj) st16(QN + (unsigned)row * 1024 + pn * 256 + bj * 128 + wc * 32 + 8 * fq, pack8(acc[ai][bj][m][0] * r, acc[ai][bj][m][1] * r));
            } else {
                const int j0 = 16 * (wc & 1) + 4 * fq; const f32x4 cs = *(const f32x4*)(cosT + (unsigned)row * 32u + j0), sn = *(const f32x4*)(sinT + (unsigned)row * 32u + j0);
                _Pragma("unroll") for (int bj = 0; bj < 2; ++bj) { const int h = (pn - 4) * 4 + 2 * bj + (wc >> 1); bf16_t* dq = QR + (unsigned)row * 512 + h * 64;
                    rope_store2v(dq, acc[ai][bj][m][0] * r, cs[0], cs[1], sn[0], sn[1], j0); rope_store2v(dq, acc[ai][bj][m][1] * r, cs[2], cs[3], sn[2], sn[3], j0 + 2); }
            }
        )
    }
};
struct EpiKV { static constexpr bool PERM = true, AFTER_DRAIN = false;
    const float* ssqkv; bf16_t *KN, *VT;
    __device__ __forceinline__ void operator()(AccRef acc, const Unit& u, int wr, int wc, int fr, int fq) const {
        const int h = u.pn, cw = wc * 32 + 8 * fq;
        EPI_ROWS(
            const float r = rstd_of(ssqkv, row, fq, 4, 1.f / 256.f);
            st16(KN + (unsigned)row * 1024 + h * 128 + cw, pack8(acc[ai][0][m][0] * r, acc[ai][0][m][1] * r));
            const int odd = fr & 1;
            const unsigned voff2 = (unsigned)((((row >> 13) * 8 + h) * 128 + cw + odd) * SEQ + ((row & 8191) & ~1));
            _Pragma("unroll") for (int n = 0; n < 2; ++n) { const u32x2 w = pack4(acc[ai][1][m][n] * r);
                const unsigned px = (unsigned)__builtin_amdgcn_update_dpp(0, (int)w.x, 0xB1, 0xF, 0xF, true), py = (unsigned)__builtin_amdgcn_update_dpp(0, (int)w.y, 0xB1, 0xF, 0xF, true);
                const unsigned ox = odd ? ((px >> 16) | (w.x & 0xffff0000u)) : ((w.x & 0xffffu) | (px << 16));
                const unsigned oy = odd ? ((py >> 16) | (w.y & 0xffff0000u)) : ((w.y & 0xffffu) | (py << 16));
                const unsigned vo = voff2 + (unsigned)(4 * n) * SEQ;
                st4(VT + vo, ox); st4(VT + vo + 2u * SEQ, oy); }
        )
    }
};
template <bool ADD> struct EpiMulAdd { static constexpr bool PERM = true, AFTER_DRAIN = false;
    const bf16_t* mul; const bf16_t* add; bf16_t* O;
    __device__ __forceinline__ void operator()(AccRef acc, const Unit& u, int wr, int wc, int fr, int fq) const {
        const int cw = u.pn * 256 + wc * 32 + 8 * fq;
        EPI_ROWS(
            _Pragma("unroll") for (int bj = 0; bj < 2; ++bj) { const unsigned off = (unsigned)row * 1024u + (unsigned)(bj * 128 + cw);
                const u32x4 g = *(const u32x4*)(mul + off); f32x4 v0 = acc[ai][bj][m][0] * unlo(g), v1 = acc[ai][bj][m][1] * unhi(g);
                if (ADD) { const u32x4 a = *(const u32x4*)(add + off); v0 += unlo(a); v1 += unhi(a); }
                st16(O + off, pack8(v0, v1)); }
        )
    }
};
template <bool MUL> struct EpiRes { static constexpr bool PERM = true, AFTER_DRAIN = false;
    const float* xin; float* xout; bf16_t* xb; float* ssq; const bf16_t* mul;
    __device__ __forceinline__ void operator()(AccRef acc, const Unit& u, int wr, int wc, int fr, int fq) const {
        const int cw = u.pn * 256 + wc * 32 + 8 * fq;
        EPI_ROWS(
            float s = 0.f;
            _Pragma("unroll") for (int bj = 0; bj < 2; ++bj) { const unsigned off = (unsigned)row * 1024u + (unsigned)(bj * 128 + cw);
                f32x4 v0 = acc[ai][bj][m][0], v1 = acc[ai][bj][m][1];
                if (MUL) { const u32x4 g = *(const u32x4*)(mul + off); v0 *= unlo(g); v1 *= unhi(g); }
                v0 += *(const f32x4*)(xin + off); v1 += *(const f32x4*)(xin + off + 4);
                st16f(xout + off, v0); st16f(xout + off + 4, v1); st16(xb + off, pack8(v0, v1)); s += sq4(v0) + sq4(v1); }
            s = quad_reduce(s); if (fq == 0) st4f(ssq + (unsigned)row * 16u + (unsigned)(u.pn * 4 + wc), s);
        )
    }
};
struct EpiGU { static constexpr bool PERM = true, AFTER_DRAIN = false;
    const float* ssq; bf16_t* H;
    __device__ __forceinline__ void operator()(AccRef acc, const Unit& u, int wr, int wc, int fr, int fq) const {
        const int cw = u.pn * 128 + wc * 32 + 8 * fq;
        EPI_ROWS(
            const float r = rstd_of(ssq, row, fq, 16, 1.f / 1024.f);
            f32x4 g0 = acc[ai][0][m][0] * r, g1 = acc[ai][0][m][1] * r; const f32x4 u0 = acc[ai][1][m][0] * r, u1 = acc[ai][1][m][1] * r;
            _Pragma("unroll") for (int e = 0; e < 4; ++e) { g0[e] = g0[e] * sigm(g0[e]) * u0[e]; g1[e] = g1[e] * sigm(g1[e]) * u1[e]; }
            st16(H + (unsigned)row * DFF + cw, pack8(g0, g1));
        )
    }
};

template <class Epi> __device__ __forceinline__ void run_gemm(LAS unsigned char* lds, const bf16_t* A, const bf16_t* Bt, int N, int K, int cid, const Epi& E) {
    asm volatile("" : "+s"(K), "+s"(N));
    pg8::Gemm g{A, Bt, M, N, K}; pg8::StaticOrder S; S.init(M, N, (int)gridDim.x, cid);
    pg8::gemm_phase<Epi, pg8::StaticOrder, true, true>(lds, g, S, E);
}

enum { MAP_ID = 0, MAP_IN = 1, MAP_Q = 2, MAP_GATE = 3, MAP_UP = 4 };
__device__ __forceinline__ int maprow(int map, int n) {
    switch (map) {
        case MAP_IN: if (n < 1280) return n; else { const int j = (n - 1280) & 31, s = (n - 1280) >> 5; return 1280 + 2 * j + s; }
        case MAP_Q: { const int h = n / 192, d = n % 192; if (d < 128) return h * 128 + d; const int j = (d - 128) & 31, s = (d - 128) >> 5; return 1024 + h * 64 + 2 * j + s; }
        case MAP_GATE: return (n >> 7) * 256 + (n & 127);
        case MAP_UP: return (n >> 7) * 256 + 128 + (n & 127);
        default: return n;
    }
}
__device__ __forceinline__ void cvt_item(const float* W, int ld, int ncol0, int N, int K, bf16_t* WT, const float* gain, float cs, int map, int item, LAS float* scr, int lane) {
    const int nblk = N / 32, kb = item / nblk, nb = item % nblk, k0 = 64 * kb, n0 = 32 * nb;
#pragma unroll
    for (int i = 0; i < 32; ++i) { const int kk = 2 * i + (lane >> 5); scr[kk * 33 + (lane & 31)] = __builtin_nontemporal_load(W + (size_t)(k0 + kk) * ld + ncol0 + n0 + (lane & 31)); }
    const int c = lane & 7;
    f32x4 g0 = (f32x4){cs, cs, cs, cs}, g1 = g0;
    if (gain) { g0 = *(const f32x4*)(gain + k0 + 8 * c) * cs; g1 = *(const f32x4*)(gain + k0 + 8 * c + 4) * cs; }
    asm volatile("s_waitcnt lgkmcnt(0)" ::: "memory");
#pragma unroll
    for (int j = 0; j < 4; ++j) { const int n = (lane >> 3) + 8 * j; const LAS float* sp = scr + (8 * c) * 33 + n;
        u32x4 o; o.x = pk(sp[0 * 33] * g0[0], sp[1 * 33] * g0[1]); o.y = pk(sp[2 * 33] * g0[2], sp[3 * 33] * g0[3]); o.z = pk(sp[4 * 33] * g1[0], sp[5 * 33] * g1[1]); o.w = pk(sp[6 * 33] * g1[2], sp[7 * 33] * g1[3]);
        st16(WT + (size_t)maprow(map, n0 + n) * K + k0 + 8 * c, o); }
    asm volatile("s_waitcnt lgkmcnt(0)" ::: "memory");
}

struct Args { const float* in[22]; float* out; unsigned char* ws; double invfreq[32]; };

__device__ __forceinline__ void weights_phase(const Args& a, int l_, LAS unsigned char* lds) {
    int l = l_; asm volatile("" : "+s"(l));
    int tid_ = threadIdx.x; asm volatile("" : "+v"(tid_)); const int tid = tid_, lane = tid & 63, wave = tid >> 6;
    LAS float* scr = (LAS float*)(lds + wave * 16384);
    const int gw = blockIdx.x * 8 + wave, NGW = gridDim.x * 8;
    unsigned char* ws = fresh(a.ws);
    const float* w_in = a.in[4] + (size_t)l * DM * INW; const float* norm_mix = a.in[3] + l * DM;
    const float* w_uq = a.in[9] + (size_t)l * 512 * 1536; const float* q_norm = a.in[7] + l * 512;
    const float* w_ukv = a.in[10] + (size_t)l * 256 * 2048; const float* kv_norm = a.in[8] + l * 256;
    const float* w_b = a.in[12] + (size_t)l * DM * DM; const float* w_o = a.in[13] + (size_t)l * DM * DM;
    const float* norm_ffn = a.in[14] + l * DM; const float* w_gate = a.in[15] + (size_t)l * DM * DFF; const float* w_up = a.in[16] + (size_t)l * DM * DFF;
    const float* w_down = a.in[17] + (size_t)l * DFF * DM; const float* norm_ple = a.in[18] + l * DM; const float* w_pg = a.in[19] + (size_t)l * DM * DM;
    const float* w_ple = a.in[20] + (size_t)l * PLE * DM;
    const float C2 = 0.07216878364870322f * 1.4426950408889634f;
    constexpr int I0 = 16 * 42, I1 = 16 * 64, I2 = 8 * 48, I3 = 4 * 64, I4 = 16 * 32, I5 = 16 * 32, I6 = 16 * 88, I7 = 16 * 88, I8 = 44 * 32, I9 = 16 * 32, I10 = 4 * 32;
    constexpr int NIT = I0 + I1 + I2 + I3 + I4 + I5 + I6 + I7 + I8 + I9 + I10;
    for (int it = gw; it < NIT; it += NGW) {
        int r = it;
        if (r < I0) { cvt_item(w_in, INW, 0, 1344, DM, (bf16_t*)(ws + W_IN), norm_mix, 1.f, MAP_IN, r, scr, lane); continue; } r -= I0;
        if (r < I1) { cvt_item(w_in, INW, 1344, 2048, DM, (bf16_t*)(ws + W_G), norm_mix, 1.f, MAP_ID, r, scr, lane); continue; } r -= I1;
        if (r < I2) { cvt_item(w_uq, 1536, 0, 1536, 512, (bf16_t*)(ws + W_UQ), q_norm, C2, MAP_Q, r, scr, lane); continue; } r -= I2;
        if (r < I3) { cvt_item(w_ukv, 2048, 0, 2048, 256, (bf16_t*)(ws + W_UKV), kv_norm, 1.f, MAP_ID, r, scr, lane); continue; } r -= I3;
        if (r < I4) { cvt_item(w_b, DM, 0, DM, DM, (bf16_t*)(ws + W_B), nullptr, 1.f, MAP_ID, r, scr, lane); continue; } r -= I4;
        if (r < I5) { cvt_item(w_o, DM, 0, DM, DM, (bf16_t*)(ws + W_O), nullptr, 1.f, MAP_ID, r, scr, lane); continue; } r -= I5;
        if (r < I6) { cvt_item(w_gate, DFF, 0, DFF, DM, (bf16_t*)(ws + W_GU), norm_ffn, 1.f, MAP_GATE, r, scr, lane); continue; } r -= I6;
        if (r < I7) { cvt_item(w_up, DFF, 0, DFF, DM, (bf16_t*)(ws + W_GU), norm_ffn, 1.f, MAP_UP, r, scr, lane); continue; } r -= I7;
        if (r < I8) { cvt_item(w_down, DM, 0, DM, DFF, (bf16_t*)(ws + W_D), nullptr, 1.f, MAP_ID, r, scr, lane); continue; } r -= I8;
        if (r < I9) { cvt_item(w_pg, DM, 0, DM, DM, (bf16_t*)(ws + W_PG), norm_ple, 1.f, MAP_ID, r, scr, lane); continue; } r -= I9;
        cvt_item(w_ple, DM, 0, DM, PLE, (bf16_t*)(ws + W_PLE), nullptr, 1.f, MAP_ID, r, scr, lane);
    }
    const int gt = blockIdx.x * NTHREADS + tid, NGT = gridDim.x * NTHREADS;
    {
        const float* w_pool = a.in[5] + (size_t)l * 4 * 128 * 128; const float* pscale = a.in[6] + l * 512; const float* w_a = a.in[11] + (size_t)l * 512 * DM;
        bf16_t* WA = (bf16_t*)(ws + W_A);
        for (int it = gt; it < 1024 * 64; it += NGT) {
            const int n = it & 1023, cb = it >> 10, g = cb >> 4, c0 = (cb & 15) * 8;
            float accv[8];
#pragma unroll
            for (int i = 0; i < 8; ++i) accv[i] = 0.f;
            const float* wp = w_pool + ((size_t)g * 128 + c0) * 128;
#pragma unroll 4
            for (int d = 0; d < 128; d += 4) {
                const f32x4 psv = *(const f32x4*)(pscale + g * 128 + d);
                const float t0 = psv[0] * w_a[(size_t)(g * 128 + d) * DM + n], t1 = psv[1] * w_a[(size_t)(g * 128 + d + 1) * DM + n], t2 = psv[2] * w_a[(size_t)(g * 128 + d + 2) * DM + n], t3 = psv[3] * w_a[(size_t)(g * 128 + d + 3) * DM + n];
#pragma unroll
                for (int i = 0; i < 8; ++i) { const f32x4 wv4 = *(const f32x4*)(wp + i * 128 + d); accv[i] += (wv4[0] * t0 + wv4[1] * t1) + (wv4[2] * t2 + wv4[3] * t3); } }
            u32x4 o; o.x = pk(accv[0], accv[1]); o.y = pk(accv[2], accv[3]); o.z = pk(accv[4], accv[5]); o.w = pk(accv[6], accv[7]);
            st16(WA + (size_t)n * 512 + g * 128 + c0, o);
        }
    }
    {
        const float* p = a.in[1] + (size_t)l * M * PLE; bf16_t* PB = (bf16_t*)(ws + WS_PB);
        for (int i = gt; i < M * PLE / 8; i += NGT) { const f32x4 v0 = __builtin_nontemporal_load((const f32x4*)(p + (size_t)i * 8)), v1 = __builtin_nontemporal_load((const f32x4*)(p + (size_t)i * 8 + 4)); st16(PB + (size_t)i * 8, pack8(v0, v1)); }
    }
}

__device__ __forceinline__ void prologue_phase(const Args& a) {
    int tid_ = threadIdx.x; asm volatile("" : "+v"(tid_)); const int tid = tid_, lane = tid & 63, wave = tid >> 6;
    const int gw = blockIdx.x * 8 + wave, NGW = gridDim.x * 8, gt = blockIdx.x * NTHREADS + tid, NGT = gridDim.x * NTHREADS;
    unsigned char* ws = fresh(a.ws);
    float* ssq = (float*)(ws + WS_SSQ) + (size_t)ST_X * M * 16;
    for (int i = gt; i < 192 * DM / 8; i += NGT) st16((bf16_t*)(ws + W_IN) + (size_t)1344 * DM + (size_t)i * 8, (u32x4){0u, 0u, 0u, 0u});
    const float* x = a.in[0]; bf16_t* XB = (bf16_t*)(ws + A_XB0);
    for (int r = gw; r < M; r += NGW) {
        const f32x4* xr = (const f32x4*)(x + (size_t)r * DM) + lane; float s = 0.f; f32x4 v[4];
#pragma unroll
        for (int j = 0; j < 4; ++j) { v[j] = __builtin_nontemporal_load(xr + 64 * j); s += sq4(v[j]); }
#pragma unroll
        for (int o = 1; o < 64; o <<= 1) s += __shfl_xor(s, o);
        u32x2* o8 = (u32x2*)(XB + (size_t)r * DM) + lane;
#pragma unroll
        for (int j = 0; j < 4; ++j) { u32x2 w; w.x = pk(v[j][0], v[j][1]); w.y = pk(v[j][2], v[j][3]); st8(o8 + 64 * j, w); }
        if (lane < 16) st4f(ssq + (size_t)r * 16 + lane, (lane == 0) ? s : 0.f);
    }
    const int* pos = (const int*)a.in[2]; float* cosT = (float*)(ws + WS_COS); float* sinT = (float*)(ws + WS_SIN);
    for (int i = gt; i < M * 32; i += NGT) {
        const int r = i >> 5, j = i & 31; const double ang = (double)pos[r] * a.invfreq[j];
        const double k = rint(ang * 0.15915494309189535); double t = fma(-k, 6.283185307179586, ang); t = fma(-k, 2.4492935982947064e-16, t);
        const double t2 = t * t; double c = 1.0, s = t, tc = 1.0, ts = t;
#pragma unroll
        for (int q = 1; q <= 14; ++q) { tc *= -t2 * (1.0 / ((2.0 * q - 1.0) * (2.0 * q))); c += tc; ts *= -t2 * (1.0 / ((2.0 * q) * (2.0 * q + 1.0))); s += ts; }
        st4f(cosT + i, (float)c); st4f(sinT + i, (float)s);
    }
}

__device__ __forceinline__ void pool_phase(const bf16_t* U, bf16_t* P) {
    int tid_ = threadIdx.x; asm volatile("" : "+v"(tid_)); const int gt = blockIdx.x * NTHREADS + tid_, NGT = gridDim.x * NTHREADS;
    for (int it = gt; it < M * 64; it += NGT) {
        const int row = it >> 6, ch = it & 63, g = ch >> 4, w = 2 << g, tl = row & (SEQ - 1), n = (tl + 1 < w) ? tl + 1 : w;
        const bf16_t* src = U + (size_t)row * 512 + ch * 8;
        const u32x4 own = ld16c(src); f32x4 s0 = unlo(own), s1 = unhi(own); const f32x4 o0 = s0, o1 = s1;
        u32x4 wv[15];
#pragma unroll
        for (int j = 1; j < 16; ++j) wv[j - 1] = (j < n) ? ld16c(src - (size_t)j * 512) : (u32x4){0u, 0u, 0u, 0u};
#pragma unroll
        for (int j = 1; j < 16; ++j) { s0 += unlo(wv[j - 1]); s1 += unhi(wv[j - 1]); }
        const float inv = 1.f / (float)n;
        st16(P + (size_t)row * 512 + ch * 8, pack8(s0 * inv - o0, s1 * inv - o1));
    }
}
__device__ __forceinline__ void final_phase(float* X, const float* ssq, const float* gn) {
    int tid_ = threadIdx.x; asm volatile("" : "+v"(tid_)); const int lane = tid_ & 63, wave = tid_ >> 6;
    const int gw = blockIdx.x * 8 + wave, NGW = gridDim.x * 8;
    f32x4 g[4];
#pragma unroll
    for (int j = 0; j < 4; ++j) g[j] = *(const f32x4*)(gn + 4 * lane + 256 * j);
    for (int r = gw; r < M; r += NGW) {
        float t = (lane < 16) ? ssq[(size_t)r * 16 + lane] : 0.f;
        t += __shfl_xor(t, 1); t += __shfl_xor(t, 2); t += __shfl_xor(t, 4); t += __shfl_xor(t, 8);
        t = __shfl(t, 0);
        const float rs = rsqrtf(t * (1.f / 1024.f) + EPS);
        f32x4* xr = (f32x4*)(X + (size_t)r * DM) + lane;
        f32x4 v[4];
#pragma unroll
        for (int j = 0; j < 4; ++j) v[j] = __builtin_nontemporal_load(xr + 64 * j);
#pragma unroll
        for (int j = 0; j < 4; ++j) __builtin_nontemporal_store(v[j] * rs * g[j], xr + 64 * j);
    }
}

constexpr int KROW = 400, VROW = 144, KBUF = 64 * KROW, VBUF = 128 * VROW, VBASE = 2 * KBUF;
__device__ __forceinline__ float max3f(float a, float b, float c) { float r; asm("v_max3_f32 %0, %1, %2, %3" : "=v"(r) : "v"(a), "v"(b), "v"(c)); return r; }
__device__ __forceinline__ void attn_unit(LAS unsigned char* lds, int b, int h, int qb, const bf16_t* QN, const bf16_t* QR, const bf16_t* KN, const bf16_t* KPE, const bf16_t* VT, bf16_t* O) {
    int tid_ = threadIdx.x; asm volatile("" : "+v"(tid_)); const int tid = tid_, lane = tid & 63, wid = __builtin_amdgcn_readfirstlane(tid >> 6), q = lane & 31, hi = lane >> 5;
    const bool grpB = wid >= 4;
    const size_t rowbase = (size_t)b * SEQ; const int q0 = qb * 256, qrow = q0 + wid * 32 + q;
    bf16x8 qf[12];
    { const bf16_t* qnp = QN + (rowbase + qrow) * 1024 + h * 128 + 8 * hi; const bf16_t* qrp = QR + (rowbase + qrow) * 512 + h * 64 + 8 * hi;
#pragma unroll
      for (int d0 = 0; d0 < 8; ++d0) qf[d0] = __builtin_bit_cast(bf16x8, ld16c(qnp + 16 * d0));
#pragma unroll
      for (int d0 = 0; d0 < 4; ++d0) qf[8 + d0] = __builtin_bit_cast(bf16x8, ld16c(qrp + 16 * d0)); }
    f32x16 o[4];
#pragma unroll
    for (int i = 0; i < 4; ++i) o[i] = (f32x16){};
    float mrun = 0.f, lrun = 0.f;
    f32x16 negm = (f32x16){};
    const int NT = 4 * (qb + 1);
    const int kk0 = tid >> 4, kc0 = tid & 15;
    const bf16_t* ksrc = KN + (rowbase + kk0) * 1024 + h * 128 + kc0 * 8;
    const int kdst = kk0 * KROW + kc0 * 16;
    const int rk = tid >> 3, rc = tid & 7;
    const bf16_t* rsrc = KPE + (rowbase + rk) * 64 + rc * 8;
    const int rdst = rk * KROW + 256 + rc * 16;
    const int vd0 = tid >> 3, vc0 = tid & 7;
    const bf16_t* vsrc = VT + ((size_t)(b * 8 + h) * 128 + vd0) * SEQ + vc0 * 8;
    const int vdst = VBASE + vd0 * VROW + vc0 * 16;
    u32x4 sk0, sk1, sr, sv0, sv1;
#define ATT_LOAD(t) do { sk0 = ld16c(ksrc + (size_t)(t) * 64 * 1024); sk1 = ld16c(ksrc + (size_t)(t) * 64 * 1024 + 32 * 1024); sr = ld16c(rsrc + (size_t)(t) * 64 * 64); \
        sv0 = ld16c(vsrc + (t) * 64); sv1 = ld16c(vsrc + (size_t)64 * SEQ + (t) * 64); } while (0)
#define ATT_STORE(kb, vb) do { LAS unsigned char* bk = lds + (kb) * KBUF; LAS unsigned char* bv = lds + (vb) * VBUF; *(LAS u32x4*)(bk + kdst) = sk0; *(LAS u32x4*)(bk + kdst + 32 * KROW) = sk1; *(LAS u32x4*)(bk + rdst) = sr; \
        *(LAS u32x4*)(bv + vdst) = sv0; *(LAS u32x4*)(bv + vdst + 64 * VROW) = sv1; } while (0)
#define ATT_PV(vb) do { const LAS unsigned char* bv = lds + VBASE + (vb) * VBUF + vfrag; __builtin_amdgcn_s_setprio(1); \
        _Pragma("unroll") for (int ks = 0; ks < 4; ++ks) { const bf16x8 pb = __builtin_bit_cast(bf16x8, pw[ks]); \
            _Pragma("unroll") for (int db = 0; db < 4; ++db) { const bf16x8 vf = *(const LAS bf16x8*)(bv + db * 32 * VROW + ks * 32); o[db] = __builtin_amdgcn_mfma_f32_32x32x16_bf16(vf, pb, o[db], 0, 0, 0); } } __builtin_amdgcn_s_setprio(0); } while (0)
    const int pr = (q & ~12) | ((q & 4) << 1) | ((q & 8) >> 1);
    const int kfrag = pr * KROW + 16 * hi, vfrag = q * VROW + 16 * hi;
    u32x4 pw[4]; bool pend = false;
    int vb_prev = 0, vb_cur = 0, vb_next = 1;
    ATT_LOAD(0); ATT_STORE(0, 0); ATT_LOAD(1); __syncthreads();
#pragma unroll
    for (int i = 0; i < 12; ++i) asm volatile("" :: "v"(qf[i]));
    for (int t = 0; t < NT; ++t) {
        bool staged = false;
        if (pend) { ATT_PV(vb_prev); pend = false; }
        const int kv0 = 64 * t;
        if (kv0 <= q0 + wid * 32 + 31) {
            const LAS unsigned char* bb = lds + (t & 1) * KBUF;
            f32x16 p0 = negm, p1 = negm;
            __builtin_amdgcn_s_setprio(1);
#pragma unroll
            for (int d0 = 0; d0 < 12; ++d0) {
                const bf16x8 a0 = *(const LAS bf16x8*)(bb + kfrag + d0 * 32), a1 = *(const LAS bf16x8*)(bb + kfrag + 32 * KROW + d0 * 32);
                p0 = __builtin_amdgcn_mfma_f32_32x32x16_bf16(a0, qf[d0], p0, 0, 0, 0); p1 = __builtin_amdgcn_mfma_f32_32x32x16_bf16(a1, qf[d0], p1, 0, 0, 0);
            }
            __builtin_amdgcn_s_setprio(0);
            if (kv0 + 63 > q0 + wid * 32) {
#pragma unroll
                for (int r = 0; r < 16; ++r) { const int kv = kv0 + 16 * (r >> 3) + 8 * hi + (r & 7); if (kv > qrow) p0[r] = -1e30f; if (kv + 32 > qrow) p1[r] = -1e30f; }
            }
            float mt = fmaxf(p0[0], p1[0]);
#pragma unroll
            for (int r = 1; r < 16; ++r) mt = fmaxf(mt, fmaxf(p0[r], p1[r]));
            mt = fmaxf(mt, __shfl_xor(mt, 32));
            if (grpB && t + 1 < NT) { ATT_STORE((t + 1) & 1, vb_next); staged = true; if (t + 2 < NT) ATT_LOAD(t + 2); }
            if (t == 0 || __any(mt > 8.f)) {
                const float dl = (t == 0) ? mt : fmaxf(mt, 0.f), alpha = __builtin_amdgcn_exp2f(-dl); mrun += dl; lrun *= alpha;
#pragma unroll
                for (int r = 0; r < 16; ++r) { p0[r] -= dl; p1[r] -= dl; }
#pragma unroll
                for (int i = 0; i < 4; ++i) o[i] *= alpha;
#pragma unroll
                for (int r = 0; r < 16; ++r) negm[r] = -mrun;
            }
            float ls = 0.f;
#pragma unroll
            for (int r = 0; r < 16; ++r) { p0[r] = __builtin_amdgcn_exp2f(p0[r]); p1[r] = __builtin_amdgcn_exp2f(p1[r]); ls += p0[r] + p1[r]; }
            lrun += ls;
            pw[0] = (u32x4){pk(p0[0], p0[1]), pk(p0[2], p0[3]), pk(p0[4], p0[5]), pk(p0[6], p0[7])};
            pw[1] = (u32x4){pk(p0[8], p0[9]), pk(p0[10], p0[11]), pk(p0[12], p0[13]), pk(p0[14], p0[15])};
            pw[2] = (u32x4){pk(p1[0], p1[1]), pk(p1[2], p1[3]), pk(p1[4], p1[5]), pk(p1[6], p1[7])};
            pw[3] = (u32x4){pk(p1[8], p1[9]), pk(p1[10], p1[11]), pk(p1[12], p1[13]), pk(p1[14], p1[15])};
            if (grpB) pend = true; else { if (t + 1 < NT) { ATT_STORE((t + 1) & 1, vb_next); staged = true; if (t + 2 < NT) ATT_LOAD(t + 2); } ATT_PV(vb_cur); }
        }
        if (t + 1 < NT && !staged) { ATT_STORE((t + 1) & 1, vb_next); if (t + 2 < NT) ATT_LOAD(t + 2); }
        vb_prev = vb_cur; vb_cur = vb_next; vb_next = (vb_next == 2) ? 0 : vb_next + 1;
        __syncthreads();
    }
    if (pend) ATT_PV(vb_prev);
#undef ATT_LOAD
#undef ATT_STORE
#undef ATT_PV
    const float l = lrun + __shfl_xor(lrun, 32), inv = 1.f / l;
    bf16_t* op = O + (rowbase + qrow) * 1024 + h * 128 + 4 * hi;
#pragma unroll
    for (int db = 0; db < 4; ++db)
#pragma unroll
        for (int g = 0; g < 4; ++g) { u32x2 w; w.x = pk(o[db][4 * g] * inv, o[db][4 * g + 1] * inv); w.y = pk(o[db][4 * g + 2] * inv, o[db][4 * g + 3] * inv); st8(op + 32 * db + 8 * g, w); }
    __syncthreads();
}
__device__ __forceinline__ void attn_phase(LAS unsigned char* lds, const bf16_t* QN, const bf16_t* QR, const bf16_t* KN, const bf16_t* KPE, const bf16_t* VT, bf16_t* O) {
    for (int pi = blockIdx.x; pi < 256; pi += gridDim.x) {
        const int bh = pi >> 4, s = pi & 15;
        attn_unit(lds, bh >> 3, bh & 7, 31 - s, QN, QR, KN, KPE, VT, O);
        attn_unit(lds, bh >> 3, bh & 7, s, QN, QR, KN, KPE, VT, O);
    }
}

#define XB_TMO      128
#define XB_XCNT(j)  (256  + 64 * (j))
#define XB_XSUB(j)  (1280 + 64 * (j))
#define XB_XGEN(j)  (2304 + 64 * (j))
#define XB_TOP      3328
#define XB_TOPGEN   3392
#define XCD_BAR_WORDS 3456
#define XB_SPIN_CAP (1u << 18)

__device__ __forceinline__ unsigned xb_ld(unsigned* p)              { return __hip_atomic_load(p, __ATOMIC_RELAXED, __HIP_MEMORY_SCOPE_AGENT); }
__device__ __forceinline__ unsigned xb_add(unsigned* p, unsigned v) { return __hip_atomic_fetch_add(p, v, __ATOMIC_RELAXED, __HIP_MEMORY_SCOPE_AGENT); }
__device__ __forceinline__ unsigned xb_xcc_id() { return (unsigned)__builtin_amdgcn_s_getreg((3 << 11) | 20) & 0xFu; }
#define XB_SPIN(cond, bar) do { unsigned _sp = 0; while (cond) { __builtin_amdgcn_s_sleep(1); \
    if ((++_sp & 255u) == 0u) { if (xb_ld(&(bar)[XB_TMO])) break; if (_sp > XB_SPIN_CAP) { atomicAdd(&(bar)[XB_TMO], 1u); break; } } } } while (0)

struct XcdBarrier {
    unsigned* bar; unsigned x;
    volatile LAS unsigned* st;
};

__device__ __forceinline__ XcdBarrier xcd_barrier_post(unsigned* bar, volatile LAS unsigned* st) {
    XcdBarrier b; b.bar = bar; b.x = xb_xcc_id(); b.st = st;
    if (threadIdx.x == 0) (void)xb_add(&bar[XB_XCNT(b.x)], 1u);
    return b;
}
__device__ __forceinline__ void xcd_barrier_complete(unsigned* bar, unsigned x, unsigned& nloc, unsigned& nx) {
    const unsigned G = gridDim.x * gridDim.y * gridDim.z;
    unsigned sum, cnt, mine, sp = 0u;
    for (;;) {
        sum = 0u; cnt = 0u; mine = 0u;
#pragma unroll
        for (unsigned j = 0; j < 16; ++j) { const unsigned c = xb_ld(&bar[XB_XCNT(j)]); sum += c; cnt += (c > 0u) ? 1u : 0u; mine = (j == x) ? c : mine; }
        if (sum == G) break;
        __builtin_amdgcn_s_sleep(1);
        if ((++sp & 255u) == 0u) { if (xb_ld(&bar[XB_TMO])) break; if (sp > XB_SPIN_CAP) { atomicAdd(&bar[XB_TMO], 1u); break; } }
    }
    nloc = mine > 0u ? mine : 1u; nx = cnt > 0u ? cnt : 1u;
}

__device__ __forceinline__ void xcd_barrier(const XcdBarrier& b) {
    asm volatile("s_waitcnt vmcnt(0)" ::: "memory");
    __syncthreads();
    if (threadIdx.x == 0) {
        unsigned* bar = b.bar;
        __builtin_amdgcn_s_waitcnt(0);
        unsigned nloc = b.st[0], nx = b.st[1];
        if (nloc == 0u) { xcd_barrier_complete(bar, b.x, nloc, nx); b.st[0] = nloc; b.st[1] = nx; }
        const unsigned old = xb_add(&bar[XB_XSUB(b.x)], 1u);
        const unsigned gen = old / nloc;
        if (old + 1u == (gen + 1u) * nloc) {
            __builtin_amdgcn_fence(__ATOMIC_RELEASE, "agent");
            asm volatile("s_waitcnt vmcnt(0)" ::: "memory");
            const unsigned og = xb_add(&bar[XB_TOP], 1u);
            const unsigned tg = og / nx;
            if (og + 1u == (tg + 1u) * nx) xb_add(&bar[XB_TOPGEN], 1u);
            else XB_SPIN(xb_ld(&bar[XB_TOPGEN]) == tg, bar);
            __builtin_amdgcn_fence(__ATOMIC_ACQUIRE, "agent");
            xb_add(&bar[XB_XGEN(b.x)], 1u);
            asm volatile("s_waitcnt vmcnt(0)" ::: "memory");
        } else {
            XB_SPIN(xb_ld(&bar[XB_XGEN(b.x)]) == gen, bar);
            __builtin_amdgcn_fence(__ATOMIC_ACQUIRE, "agent");
            asm volatile("s_waitcnt vmcnt(0)" ::: "memory");
        }
    }
    __syncthreads();
}

#ifdef DBG_STOP
__device__ __forceinline__ float bfval(const bf16_t* p, size_t i) { return __uint_as_float((unsigned)p[i] << 16); }
__device__ __forceinline__ void dbg_dump(unsigned char* ws, float* out, int k) {
    const size_t gt = (size_t)blockIdx.x * NTHREADS + threadIdx.x, NGT = (size_t)gridDim.x * NTHREADS;
    for (size_t i = gt; i < (size_t)M * 1024; i += NGT) { const size_t row = i >> 10, c = i & 1023; float v = 0.f;
        if (k == 1) v = bfval((bf16_t*)(ws + A_U), row * 512 + (c & 511)) + 2.f * bfval((bf16_t*)(ws + A_CQ), row * 512 + (c & 511)) + 4.f * bfval((bf16_t*)(ws + A_CKV), row * 256 + (c & 255)) + 8.f * bfval((bf16_t*)(ws + A_KPE), row * 64 + (c & 63));
        if (k == 2) v = bfval((bf16_t*)(ws + A_POOL), row * 512 + (c & 511)) + 2.f * bfval((bf16_t*)(ws + A_QN), i) + 4.f * bfval((bf16_t*)(ws + A_QR), row * 512 + (c & 511)) + 8.f * bfval((bf16_t*)(ws + A_KN), i) + 16.f * bfval((bf16_t*)(ws + A_VT), i);
        if (k == 3) v = bfval((bf16_t*)(ws + A_QN), i);
        if (k == 4) v = bfval((bf16_t*)(ws + A_SGA), i) + 2.f * bfval((bf16_t*)(ws + A_SGB), i);
        if (k == 6) v = bfval((bf16_t*)(ws + A_HMID), row * DFF + c) + 2.f * bfval((bf16_t*)(ws + A_HMID), row * DFF + 1024 + c) + 4.f * bfval((bf16_t*)(ws + A_HMID), row * DFF + 1792 + c);
        st4f(out + i, v); }
}
#ifndef DBG_LAYER
#define DBG_LAYER 0
#endif
#define DBG(k) do { if (DBG_STOP == (k) && l == DBG_LAYER) { if ((k) != 5 && (k) != 7 && (k) != 8) dbg_dump(a.ws, a.out, (k)); return; } } while (0)
#else
#define DBG(k) do {} while (0)
#endif
#define BP(off) ((bf16_t*)(ws + (off)))
#define CBP(off) ((const bf16_t*)(ws + (off)))
#define SSQP(idx) ((float*)(ws + WS_SSQ) + (size_t)(idx) * M * 16)
#define GSYNC() do { asm volatile("s_waitcnt vmcnt(0) lgkmcnt(0)" ::: "memory"); xcd_barrier(bar); } while (0)
#define GSYNC_CG() do { asm volatile("s_waitcnt vmcnt(0) lgkmcnt(0)" ::: "memory"); grid.sync(); } while (0)
template <int l> __device__ __forceinline__ void layer_body(const Args& a, LAS unsigned char* lds, cg::grid_group& grid, const XcdBarrier& bar) {
#ifndef SK_W
        weights_phase(a, l, lds);
#endif
        GSYNC();
#ifndef SK_P1
        { unsigned char* ws = fresh(a.ws); const int cid = (int)blockIdx.x;
          EpiZ E{SSQP(ST_X), BP(A_U), BP(A_CQ), BP(A_CKV), BP(A_KPE), SSQP(ST_Q), SSQP(ST_KV), (const float*)(ws + WS_COS), (const float*)(ws + WS_SIN)};
          run_gemm(lds, CBP(A_XB0), CBP(W_IN), 1536, 1024, cid, E); }
#endif
        GSYNC();
        DBG(1);
#ifndef SK_P2
        { unsigned char* ws = fresh(a.ws); pool_phase(CBP(A_U), BP(A_POOL)); }
        { unsigned char* ws = fresh(a.ws); const int cid = (int)blockIdx.x;
          EpiQ E{SSQP(ST_Q), BP(A_QN), BP(A_QR), (const float*)(ws + WS_COS), (const float*)(ws + WS_SIN)}; run_gemm(lds, CBP(A_CQ), CBP(W_UQ), 1536, 512, cid, E); }
        { unsigned char* ws = fresh(a.ws); const int G = (int)gridDim.x, cid = ((int)blockIdx.x + G / 2) % G;
          EpiKV E{SSQP(ST_KV), BP(A_KN), BP(A_VT)}; run_gemm(lds, CBP(A_CKV), CBP(W_UKV), 2048, 256, cid, E); }
#endif
        GSYNC();
        DBG(2);
#ifndef SK_ATT
        { unsigned char* ws = fresh(a.ws); attn_phase(lds, CBP(A_QN), CBP(A_QR), CBP(A_KN), CBP(A_KPE), CBP(A_VT), BP(A_QN)); }
#endif
        GSYNC();
        DBG(3);
#ifndef SK_P4
        { unsigned char* ws = fresh(a.ws); EpiGate E{SSQP(ST_X), 1.f / 1024.f, BP(A_SGA)}; run_gemm(lds, CBP(A_XB0), CBP(W_G), 1024, 1024, (int)blockIdx.x, E); }
        { unsigned char* ws = fresh(a.ws); EpiGate E{SSQP(ST_X), 1.f / 1024.f, BP(A_SGB)}; run_gemm(lds, CBP(A_XB0), CBP(W_G) + (size_t)1024 * 1024, 1024, 1024, (int)blockIdx.x, E); }
        { unsigned char* ws = fresh(a.ws); EpiMulAdd<false> E{CBP(A_SGA), nullptr, BP(A_SGA)}; run_gemm(lds, CBP(A_POOL), CBP(W_A), 1024, 512, (int)blockIdx.x, E); }
        { unsigned char* ws = fresh(a.ws); EpiMulAdd<true> E{CBP(A_SGB), CBP(A_SGA), BP(A_SGA)}; run_gemm(lds, CBP(A_QN), CBP(W_B), 1024, 1024, (int)blockIdx.x, E); }
#endif
        GSYNC();
        DBG(4);
#ifndef SK_P5
        { unsigned char* ws = fresh(a.ws); EpiRes<false> E{l == 0 ? a.in[0] : a.out, a.out, BP(A_XB1), SSQP(ST_1), nullptr}; run_gemm(lds, CBP(A_SGA), CBP(W_O), 1024, 1024, (int)blockIdx.x, E); }
#endif
        GSYNC();
        DBG(5);
#ifndef SK_P6
        { unsigned char* ws = fresh(a.ws); EpiGU E{SSQP(ST_1), BP(A_HMID)}; run_gemm(lds, CBP(A_XB1), CBP(W_GU), 2 * DFF, 1024, (int)blockIdx.x, E); }
#endif
        GSYNC();
        DBG(6);
#ifndef SK_P7
        { unsigned char* ws = fresh(a.ws); EpiRes<false> E{a.out, a.out, BP(A_XB2), SSQP(ST_2), nullptr}; run_gemm(lds, CBP(A_HMID), CBP(W_D), 1024, DFF, (int)blockIdx.x, E); }
#endif
        GSYNC();
        DBG(7);
#ifndef SK_P8
        { unsigned char* ws = fresh(a.ws); EpiGate E{SSQP(ST_2), 1.f / 1024.f, BP(A_G)}; run_gemm(lds, CBP(A_XB2), CBP(W_PG), 1024, 1024, (int)blockIdx.x, E); }
        { unsigned char* ws = fresh(a.ws); EpiRes<true> E{a.out, a.out, BP(A_XB0), SSQP(ST_X), CBP(A_G)}; run_gemm(lds, CBP(WS_PB), CBP(W_PLE), 1024, 256, (int)blockIdx.x, E); }
#endif
        GSYNC();
        DBG(8);
    }
__global__ void __launch_bounds__(NTHREADS) fwd_kernel(Args a) {
    extern __shared__ __attribute__((aligned(16))) unsigned char lds_raw[];
    LAS unsigned char* lds = (LAS unsigned char*)lds_raw;
    cg::grid_group grid = cg::this_grid();
    volatile LAS unsigned* bst = (volatile LAS unsigned*)(lds + 131072);
    if (threadIdx.x < 2) bst[threadIdx.x] = 0u;
    __syncthreads();
    const XcdBarrier bar = xcd_barrier_post((unsigned*)(a.ws + WS_BAR), bst);
    if (a.ws == nullptr) grid.sync();
#ifndef SK_PRO
    prologue_phase(a);
#endif
    layer_body<0>(a, lds, grid, bar);
    layer_body<1>(a, lds, grid, bar);
    { unsigned char* ws = fresh(a.ws); final_phase(a.out, SSQP(ST_X), a.in[21]); }
}

extern "C" void kernel_launch(void* const* d_in, const int* in_sizes, int n_in, void* d_out, int out_size, void* d_ws, size_t ws_size, hipStream_t stream) {
    static int grid_blocks = 0;
    if (grid_blocks == 0) {
        if (n_in != 22 || out_size != M * DM || ws_size < WS_END) { fprintf(stderr, "kernel_launch: unexpected shapes (n_in %d out %d ws %zu)\n", n_in, out_size, ws_size); grid_blocks = -1; return; }
        int dev = 0, cus = 0, per_cu = 0;
        hipGetDevice(&dev); hipDeviceGetAttribute(&cus, hipDeviceAttributeMultiprocessorCount, dev);
        hipFuncSetAttribute((const void*)fwd_kernel, hipFuncAttributeMaxDynamicSharedMemorySize, LDS_BYTES);
        if (hipOccupancyMaxActiveBlocksPerMultiprocessor(&per_cu, (const void*)fwd_kernel, NTHREADS, LDS_BYTES) != hipSuccess || per_cu < 1) per_cu = 1;
        (void)hipGetLastError();
        grid_blocks = cus * per_cu;
    }
    if (grid_blocks < 0) return;
    Args a{};
    for (int i = 0; i < 22; ++i) a.in[i] = (const float*)d_in[i];
    a.out = (float*)d_out; a.ws = (unsigned char*)d_ws;
    for (int j = 0; j < 32; ++j) a.invfreq[j] = pow(10000.0, -(double)j / 32.0);
    if (hipMemsetAsync((char*)d_ws + WS_BAR, 0, WS_BAR_BYTES, stream) != hipSuccess) { fprintf(stderr, "memset failed\n"); return; }
    void* args[] = {&a};
    hipError_t e = hipLaunchCooperativeKernel((const void*)fwd_kernel, dim3(grid_blocks), dim3(NTHREADS), args, LDS_BYTES, stream);
    if (e != hipSuccess) fprintf(stderr, "cooperative launch failed: %s (grid %d)\n", hipGetErrorString(e), grid_blocks);
}
```

```cpp
#include <hip/hip_runtime.h>
#include <hip/hip_cooperative_groups.h>
#include <cstdio>
#include <cstdint>
#include <cmath>
namespace cg = cooperative_groups;
namespace pg8 {
#define PG8_LAS __attribute__((address_space(3)))
typedef unsigned short bf16_t;
typedef short bf16x8 __attribute__((ext_vector_type(8)));
typedef float f32x4 __attribute__((ext_vector_type(4)));
typedef unsigned u32x4 __attribute__((ext_vector_type(4)));
constexpr int BM = 256, BK = 64, HALF = 128, HTB = HALF * BK * 2  , STAGE_BYTES = 8 * HTB, NXCD = 8, WGM = 8;

__host__ __device__ __forceinline__ int lds_byte(int r, int c) { const int st = (r >> 4) * 2 + (c >> 5), rr = r & 15, cc = c & 31, ob = rr * 64 + cc * 2; return st * 1024 + (ob ^ (((ob >> 9) & 1) << 5)); }
__host__ __device__ __forceinline__ void stage_rc(int b, int& R, int& C) { const int st = b / 1024, sb = b % 1024, swz = sb ^ (((sb >> 9) & 1) << 5); R = (st >> 1) * 16 + swz / 64; C = (st & 1) * 32 + (swz % 64) / 2; }
__host__ __device__ __forceinline__ int perm32(int rho) { const int n = rho >> 4, i = rho & 15; return 8 * (i >> 2) + 4 * n + (i & 3); }

struct Unit { int pm, pn; };
struct Gemm { const bf16_t* A; const bf16_t* Bt; int M, N, K; };

struct StaticOrder {
    int nM, nN, nwg, G, c;
    __host__ __device__ void init(int M, int N, int G_, int c_) { nM = M / BM; nN = N / BM; nwg = nM * nN; G = G_; c = c_; }
    __host__ __device__ bool next(int i, Unit& u) const {
        const long L = (long)i * G + c; if (L >= nwg) return false;
        int wgid = (int)L; { const int q = nwg / NXCD, r = nwg % NXCD, xcd = wgid % NXCD, off = wgid / NXCD; wgid = (xcd < r ? xcd * (q + 1) : r * (q + 1) + (xcd - r) * q) + off; }
        const int nig = WGM * nN, gid = wgid / nig, fm = gid * WGM, gsz = (nM - fm) < WGM ? (nM - fm) : WGM;
        u.pm = fm + ((wgid % nig) % gsz); u.pn = (wgid % nig) / gsz; return true;
    }
    __device__ __forceinline__ void a_ready(const Unit&) const {}
    __device__ __forceinline__ void done(const Unit&) const {}
};

__device__ __forceinline__ unsigned cvt_pk_bf16(float lo, float hi) { unsigned r; asm volatile("v_cvt_pk_bf16_f32 %0, %1, %2" : "=v"(r) : "v"(lo), "v"(hi)); return r; }
template <class Epi, class Sched, bool ALIGN_EPI = false, bool SP2 = false>
__device__ __forceinline__ void gemm_phase(PG8_LAS unsigned char* lds, const Gemm g, const Sched& S, const Epi& E) {
    int tid_ = threadIdx.x; asm volatile("" : "+v"(tid_)); const int tid = tid_, wid = __builtin_amdgcn_readfirstlane(tid >> 6), lane = tid & 63, wr = wid >> 2, wc = wid & 3, fr = lane & 15, fq = lane >> 4;
    const int K = g.K, nt = K / BK;
    unsigned voffA[2], voffB[2];
#pragma unroll
    for (int i = 0; i < 2; ++i) { int R, C; stage_rc(tid * 16 + i * 8192, R, C); const int Rb = Epi::PERM ? ((R & ~31) + perm32(R & 31)) : R;
        voffA[i] = (unsigned)(R * K + C) * 2u; voffB[i] = (unsigned)(Rb * K + C) * 2u; }
    const size_t kstep = (size_t)(BK * 2);
    const size_t hstep = (size_t)HALF * K * 2;
    const size_t tstep = 2 * hstep;
    const unsigned ldsw = (unsigned)wid * 1024u;
    const int aoff = lds_byte(wr * 64 + fr, fq * 8), boff = lds_byte(wc * 32 + fr, fq * 8);
#define PG8_SA(b, h) (((b) * 2 + (h)) * HTB)
#define PG8_SB(b, h) ((4 + (b) * 2 + (h)) * HTB)
#define PG8_STAGE(bufoff, gbase, voff) do { _Pragma("unroll") for (int _i = 0; _i < 2; ++_i) \
        __builtin_amdgcn_global_load_lds((const unsigned*)((const char*)(gbase) + (voff)[_i]), (PG8_LAS unsigned*)(lds + (bufoff) + ldsw + _i * 8192), 16, 0, 0); } while (0)
#define PG8_LDA(dst, b, h) do { _Pragma("unroll") for (int m = 0; m < 4; ++m) _Pragma("unroll") for (int k = 0; k < 2; ++k) dst[m][k] = *(const PG8_LAS bf16x8*)(lds + PG8_SA(b, h) + aoff + m * 2048 + k * 1024); } while (0)
#define PG8_LDB(dst, b, h) do { _Pragma("unroll") for (int n = 0; n < 2; ++n) _Pragma("unroll") for (int k = 0; k < 2; ++k) dst[n][k] = *(const PG8_LAS bf16x8*)(lds + PG8_SB(b, h) + boff + n * 2048 + k * 1024); } while (0)
#define PG8_MMA(ai, bj, At, Bt) do { __builtin_amdgcn_s_setprio(1); _Pragma("unroll") for (int m = 0; m < 4; ++m) _Pragma("unroll") for (int n = 0; n < 2; ++n) _Pragma("unroll") for (int k = 0; k < 2; ++k) \
        acc[ai][bj][m][n] = __builtin_amdgcn_mfma_f32_16x16x32_bf16(Bt[n][k], At[m][k], acc[ai][bj][m][n], 0, 0, 0); __builtin_amdgcn_s_setprio(0); } while (0)
#define PG8_WAIT_V(n) asm volatile("s_waitcnt vmcnt(" #n ")" ::: "memory")
#define PG8_WAIT_L(n) asm volatile("s_waitcnt lgkmcnt(" #n ")" ::: "memory")
#define PG8_BAR __builtin_amdgcn_s_barrier()
#define PG8_SCHED __builtin_amdgcn_sched_barrier(0)
    Unit cur, nxt; int ui = 0;
    if (!S.next(0, cur)) return;
    f32x4 acc[2][2][4][2];
#pragma unroll
    for (int a = 0; a < 2; ++a)
#pragma unroll
        for (int b = 0; b < 2; ++b)
#pragma unroll
            for (int m = 0; m < 4; ++m)
#pragma unroll
                for (int n = 0; n < 2; ++n) acc[a][b][m][n] = (f32x4){0.f, 0.f, 0.f, 0.f};
    bf16x8 At[4][2], B0[2][2], B1[2][2];
    const char* cA = (const char*)g.A + (size_t)cur.pm * tstep; const char* cB = (const char*)g.Bt + (size_t)cur.pn * tstep;
    S.a_ready(cur);
    if constexpr (SP2) {
        PG8_STAGE(PG8_SB(0, 0), cB, voffB); PG8_STAGE(PG8_SB(0, 1), cB + hstep, voffB); PG8_STAGE(PG8_SA(0, 0), cA, voffA); PG8_STAGE(PG8_SA(0, 1), cA + hstep, voffA);
        if (wr == 1) PG8_BAR;
        PG8_WAIT_V(2); PG8_BAR;
        PG8_STAGE(PG8_SB(1, 0), cB + kstep, voffB); PG8_STAGE(PG8_SA(1, 0), cA + kstep, voffA); PG8_STAGE(PG8_SB(1, 1), cB + hstep + kstep, voffB);
        PG8_WAIT_V(6); PG8_BAR;
    } else {
        PG8_STAGE(PG8_SB(0, 0), cB, voffB); PG8_STAGE(PG8_SA(0, 0), cA, voffA); PG8_STAGE(PG8_SB(0, 1), cB + hstep, voffB); PG8_STAGE(PG8_SA(0, 1), cA + hstep, voffA);
        if (wr == 1) PG8_BAR;
        PG8_WAIT_V(4); PG8_BAR;
        PG8_STAGE(PG8_SB(1, 0), cB + kstep, voffB); PG8_STAGE(PG8_SA(1, 0), cA + kstep, voffA); PG8_STAGE(PG8_SB(1, 1), cB + hstep + kstep, voffB);
        PG8_WAIT_V(6); PG8_BAR;
    }
    for (;;) {
        const bool has_next = S.next(ui + 1, nxt);
        const char* nA = has_next ? (const char*)g.A + (size_t)nxt.pm * tstep : cA; const char* nB = has_next ? (const char*)g.Bt + (size_t)nxt.pn * tstep : cB;
        for (int t = 0; t < nt; t += 2) {
            const bool last = (t == nt - 2);
            const char* a1 = cA + (size_t)(t + 1) * kstep;
            const char* a2 = last ? nA : cA + (size_t)(t + 2) * kstep; const char* b2 = last ? nB : cB + (size_t)(t + 2) * kstep;
            const char* a3 = a2 + kstep; const char* b3 = b2 + kstep;
            if (last && has_next) S.a_ready(nxt);
            if constexpr (SP2) {
            PG8_LDB(B0, 0, 0); PG8_LDB(B1, 0, 1); PG8_SCHED; PG8_LDA(At, 0, 0); PG8_STAGE(PG8_SA(1, 1), a1 + hstep, voffA);
            PG8_WAIT_V(8); PG8_WAIT_L(0); PG8_BAR; PG8_MMA(0, 0, At, B0); PG8_MMA(0, 1, At, B1); PG8_BAR; PG8_SCHED;
            PG8_LDA(At, 0, 1); PG8_STAGE(PG8_SB(0, 0), b2, voffB); PG8_STAGE(PG8_SB(0, 1), b2 + hstep, voffB); PG8_STAGE(PG8_SA(0, 0), a2, voffA);
            PG8_WAIT_V(8); PG8_WAIT_L(0); PG8_BAR; PG8_MMA(1, 0, At, B0); PG8_MMA(1, 1, At, B1); PG8_BAR; PG8_SCHED;
            PG8_LDB(B0, 1, 0); PG8_LDB(B1, 1, 1); PG8_SCHED; PG8_LDA(At, 1, 0); PG8_STAGE(PG8_SA(0, 1), a2 + hstep, voffA);
            PG8_WAIT_V(8); PG8_WAIT_L(0); PG8_BAR; PG8_MMA(0, 0, At, B0); PG8_MMA(0, 1, At, B1); PG8_BAR; PG8_SCHED;
            PG8_LDA(At, 1, 1); PG8_STAGE(PG8_SB(1, 0), b3, voffB); PG8_STAGE(PG8_SB(1, 1), b3 + hstep, voffB); PG8_STAGE(PG8_SA(1, 0), a3, voffA);
            PG8_WAIT_V(8); PG8_WAIT_L(0); PG8_BAR; PG8_MMA(1, 0, At, B0); PG8_MMA(1, 1, At, B1); PG8_BAR; PG8_SCHED;
            } else {
            PG8_LDB(B0, 0, 0); PG8_SCHED; PG8_LDA(At, 0, 0); PG8_STAGE(PG8_SA(1, 1), a1 + hstep, voffA);
            PG8_WAIT_L(8); PG8_BAR; PG8_WAIT_L(0); PG8_MMA(0, 0, At, B0); PG8_BAR; PG8_SCHED;
            PG8_LDB(B1, 0, 1); PG8_STAGE(PG8_SB(0, 0), b2, voffB);
            PG8_BAR; PG8_WAIT_L(0); PG8_MMA(0, 1, At, B1); PG8_BAR;
            PG8_LDA(At, 0, 1); PG8_STAGE(PG8_SA(0, 0), a2, voffA);
            PG8_BAR; PG8_WAIT_L(0); PG8_MMA(1, 0, At, B0); PG8_BAR; PG8_SCHED;
            PG8_STAGE(PG8_SB(0, 1), b2 + hstep, voffB);
            PG8_WAIT_V(6); PG8_BAR; PG8_MMA(1, 1, At, B1); PG8_BAR;
            PG8_LDB(B0, 1, 0); PG8_SCHED; PG8_LDA(At, 1, 0); PG8_STAGE(PG8_SA(0, 1), a2 + hstep, voffA);
            PG8_WAIT_L(8); PG8_BAR; PG8_WAIT_L(0); PG8_MMA(0, 0, At, B0); PG8_BAR; PG8_SCHED;
            PG8_LDB(B1, 1, 1); PG8_STAGE(PG8_SB(1, 0), b3, voffB);
            PG8_BAR; PG8_WAIT_L(0); PG8_MMA(0, 1, At, B1); PG8_BAR;
            PG8_LDA(At, 1, 1); PG8_STAGE(PG8_SA(1, 0), a3, voffA);
            PG8_BAR; PG8_WAIT_L(0); PG8_MMA(1, 0, At, B0); PG8_BAR; PG8_SCHED;
            PG8_STAGE(PG8_SB(1, 1), b3 + hstep, voffB);
            PG8_WAIT_V(6); PG8_BAR; PG8_MMA(1, 1, At, B1); PG8_BAR;
            }
        }
        if constexpr (ALIGN_EPI) { if (wr == 0) PG8_BAR; }
        if constexpr (!Epi::AFTER_DRAIN) { E(acc, cur, wr, wc, fr, fq); S.done(cur); }
        if (!has_next) break;
#pragma unroll
        for (int a = 0; a < 2; ++a)
#pragma unroll
            for (int b = 0; b < 2; ++b)
#pragma unroll
                for (int m = 0; m < 4; ++m)
#pragma unroll
                    for (int n = 0; n < 2; ++n) acc[a][b][m][n] = (f32x4){0.f, 0.f, 0.f, 0.f};
        cur = nxt; cA = nA; cB = nB; ++ui;
        if constexpr (ALIGN_EPI) { if (wr == 1) PG8_BAR; }
    }
    PG8_WAIT_V(0);
    if constexpr (!ALIGN_EPI) { if (wr == 0) PG8_BAR; }
    PG8_BAR;
    if constexpr (Epi::AFTER_DRAIN) { E.fused(acc, cur, wr, wc, fr, fq, lds, wid, lane); S.done(cur); }
#undef PG8_SA
#undef PG8_SB
#undef PG8_STAGE
#undef PG8_LDA
#undef PG8_LDB
#undef PG8_MMA
#undef PG8_WAIT_V
#undef PG8_WAIT_L
#undef PG8_BAR
#undef PG8_SCHED
}
}

#define LAS __attribute__((address_space(3)))
typedef unsigned short bf16_t;
typedef short bf16x8 __attribute__((ext_vector_type(8)));
typedef float f32x4 __attribute__((ext_vector_type(4)));
typedef float f32x16 __attribute__((ext_vector_type(16)));
typedef unsigned u32x4 __attribute__((ext_vector_type(4)));
typedef unsigned u32x2 __attribute__((ext_vector_type(2)));
using pg8::Unit;

constexpr int M = 16384, DM = 1024, SEQ = 8192, NHEAD = 8, DEPTH = 2, DFF = 2816, PLE = 256, INW = 3392;
constexpr float EPS = 1e-6f;
constexpr int NTHREADS = 512;
constexpr int LDS_BYTES = 131072 + 4096;

constexpr size_t MiB = 1u << 20;
constexpr size_t WS_COS = 1 * MiB, WS_SIN = 3 * MiB, WS_PB = 5 * MiB;
constexpr size_t W_IN = 13 * MiB, W_G = 16 * MiB, W_UQ = 20 * MiB, W_UKV = W_UQ + 3 * MiB / 2, W_A = W_UKV + MiB, W_B = W_A + MiB, W_O = W_B + 2 * MiB,
                 W_GU = W_O + 2 * MiB, W_D = W_GU + 11 * MiB, W_PG = W_D + 11 * MiB / 2, W_PLE = W_PG + 2 * MiB;
constexpr size_t ARENA = 47 * MiB;
static_assert(W_PLE + MiB / 2 <= ARENA, "weights fit");
constexpr size_t A_XB0 = ARENA, A_POOL = ARENA + 32 * MiB, A_KPE = ARENA + 48 * MiB, A_U = ARENA + 50 * MiB, A_CQ = ARENA + 66 * MiB, A_CKV = ARENA + 82 * MiB,
                 A_QN = ARENA + 90 * MiB, A_QR = ARENA + 122 * MiB, A_KN = ARENA + 138 * MiB, A_VT = ARENA + 170 * MiB, A_END = ARENA + 202 * MiB;
constexpr size_t A_SGA = ARENA + 50 * MiB, A_SGB = ARENA + 138 * MiB, A_XB1 = ARENA + 90 * MiB, A_HMID = ARENA, A_XB2 = ARENA + 122 * MiB, A_G = ARENA + 154 * MiB;
constexpr size_t WS_SSQ = A_END, WS_BAR = A_END + 3 * MiB, WS_BAR_BYTES = 16384, WS_END = WS_BAR + WS_BAR_BYTES;
static_assert(WS_END <= 256 * MiB, "workspace");
constexpr int ST_X = 0, ST_Q = 1, ST_KV = 2, ST_1 = 1, ST_2 = 2;
__device__ __forceinline__ void st8(void* p, u32x2 v) { *(u32x2*)p = v; }
__device__ __forceinline__ void st16(void* p, u32x4 v) { *(u32x4*)p = v; }
__device__ __forceinline__ void st16f(float* p, f32x4 v) { *(f32x4*)p = v; }
__device__ __forceinline__ u32x2 ld8c(const void* p) { return *(const u32x2*)p; }
__device__ __forceinline__ u32x4 ld16c(const void* p) { return *(const u32x4*)p; }
__device__ __forceinline__ f32x4 ld16cf(const float* p) { return *(const f32x4*)p; }
__device__ __forceinline__ void st4(void* p, unsigned v) { *(unsigned*)p = v; }
__device__ __forceinline__ void st4f(float* p, float v) { *p = v; }
__device__ __forceinline__ void st2(bf16_t* p, unsigned v) { *p = (bf16_t)v; }
__device__ __forceinline__ unsigned pk(float lo, float hi) { return pg8::cvt_pk_bf16(lo, hi); }
__device__ __forceinline__ float bflo(unsigned w) { return __uint_as_float(w << 16); }
__device__ __forceinline__ float bfhi(unsigned w) { return __uint_as_float(w & 0xffff0000u); }
__device__ __forceinline__ float sigm(float x) { return __builtin_amdgcn_rcpf(1.f + __expf(-x)); }
__device__ __forceinline__ u32x4 pack8(f32x4 a, f32x4 b) { u32x4 w; w.x = pk(a[0], a[1]); w.y = pk(a[2], a[3]); w.z = pk(b[0], b[1]); w.w = pk(b[2], b[3]); return w; }
__device__ __forceinline__ f32x4 unlo(u32x4 w) { return (f32x4){bflo(w.x), bfhi(w.x), bflo(w.y), bfhi(w.y)}; }
__device__ __forceinline__ f32x4 unhi(u32x4 w) { return (f32x4){bflo(w.z), bfhi(w.z), bflo(w.w), bfhi(w.w)}; }
__device__ __forceinline__ float sq4(f32x4 a) { return (a[0] * a[0] + a[1] * a[1]) + (a[2] * a[2] + a[3] * a[3]); }
__device__ __forceinline__ float quad_reduce(float s) { s += __shfl_xor(s, 16); s += __shfl_xor(s, 32); return s; }
__device__ __forceinline__ float rstd_of(const float* st, int row, int fq, int nparts, float invk) { const f32x4 v = ld16cf(st + (unsigned)row * 16u + 4u * fq);
    float s = (4 * fq < nparts) ? (v[0] + v[1]) + (v[2] + v[3]) : 0.f; s = quad_reduce(s); return rsqrtf(s * invk + EPS); }

__device__ __forceinline__ unsigned char* fresh(unsigned char* p) { size_t z = 0; asm volatile("" : "+s"(z)); return p + z; }
#define EPI_ROWS(...) _Pragma("unroll") for (int ai = 0; ai < 2; ++ai) _Pragma("unroll") for (int m = 0; m < 4; ++m) { const int row = u.pm * 256 + ai * 128 + wr * 64 + m * 16 + fr; __VA_ARGS__ if (m & 1) asm volatile("" ::: "memory"); }
typedef const f32x4 (&AccRef)[2][2][4][2];

typedef float f32x2 __attribute__((ext_vector_type(2)));
__device__ __forceinline__ void rope_store2(bf16_t* dst, f32x4 v, const float* cosT, const float* sinT, int row, int j0) {
    const unsigned to = (unsigned)row * 32u + (unsigned)j0; const f32x2 cs = *(const f32x2*)(cosT + to), sn = *(const f32x2*)(sinT + to);
    const float a0 = v[0] * cs[0] - v[1] * sn[0], a1 = v[2] * cs[1] - v[3] * sn[1], b0 = v[1] * cs[0] + v[0] * sn[0], b1 = v[3] * cs[1] + v[2] * sn[1];
    st4(dst + j0, pk(a0, a1)); st4(dst + 32 + j0, pk(b0, b1));
}
#define EFENCE() asm volatile("" ::: "memory")
__device__ __forceinline__ void rope_store2v(bf16_t* dst, f32x4 v, float c0, float c1, float s0, float s1, int j0) {
    const float a0 = v[0] * c0 - v[1] * s0, a1 = v[2] * c1 - v[3] * s1, b0 = v[1] * c0 + v[0] * s0, b1 = v[3] * c1 + v[2] * s1;
    st4(dst + j0, pk(a0, a1)); st4(dst + 32 + j0, pk(b0, b1));
}
__device__ __forceinline__ u32x2 ld8_coherent(const bf16_t* p) { const unsigned long long v = __hip_atomic_load((const unsigned long long*)p, __ATOMIC_RELAXED, __HIP_MEMORY_SCOPE_AGENT); u32x2 w; w.x = (unsigned)v; w.y = (unsigned)(v >> 32); return w; }
__device__ __forceinline__ u32x2 pack4(f32x4 a) { u32x2 w; w.x = pk(a[0], a[1]); w.y = pk(a[2], a[3]); return w; }
__device__ __forceinline__ f32x4 un4(u32x2 w) { return (f32x4){bflo(w.x), bfhi(w.x), bflo(w.y), bfhi(w.y)}; }

struct EpiZ { static constexpr bool PERM = true, AFTER_DRAIN = false;
    const float* ssqx; bf16_t *U, *CQ, *CKV, *KPE; float *ssqq, *ssqkv; const float *cosT, *sinT;
    __device__ __forceinline__ void operator()(AccRef acc, const Unit& u, int wr, int wc, int fr, int fq) const {
        const int pn = u.pn, cw = wc * 32 + 8 * fq;
        EPI_ROWS(
            const float r = rstd_of(ssqx, row, fq, 16, 1.f / 1024.f);
            if (pn < 5) {
                bf16_t* dst; float* sq = nullptr;
                if (pn < 2) dst = U + (unsigned)row * 512 + pn * 256; else if (pn < 4) { dst = CQ + (unsigned)row * 512 + (pn - 2) * 256; sq = ssqq + (pn - 2) * 4 + wc; } else { dst = CKV + (unsigned)row * 256; sq = ssqkv + wc; }
                float s = 0.f;
                _Pragma("unroll") for (int bj = 0; bj < 2; ++bj) { const f32x4 v0 = acc[ai][bj][m][0] * r, v1 = acc[ai][bj][m][1] * r; s += sq4(v0) + sq4(v1); st16(dst + bj * 128 + cw, pack8(v0, v1)); }
                if (sq) { s = quad_reduce(s); if (fq == 0) st4f(sq + (unsigned)row * 16u, s); }
            } else if (wc < 2) {
                const int j0 = 16 * wc + 4 * fq; const f32x4 cs = *(const f32x4*)(cosT + (unsigned)row * 32u + j0), sn = *(const f32x4*)(sinT + (unsigned)row * 32u + j0);
                rope_store2v(KPE + (unsigned)row * 64, acc[ai][0][m][0] * r, cs[0], cs[1], sn[0], sn[1], j0); rope_store2v(KPE + (unsigned)row * 64, acc[ai][0][m][1] * r, cs[2], cs[3], sn[2], sn[3], j0 + 2);
            }
        )
    }
};
struct EpiGate { static constexpr bool PERM = true, AFTER_DRAIN = false;
    const float* ssq; float invk; bf16_t* O;
    __device__ __forceinline__ void operator()(AccRef acc, const Unit& u, int wr, int wc, int fr, int fq) const {
        const int cw = u.pn * 256 + wc * 32 + 8 * fq;
        EPI_ROWS(
            const float r = rstd_of(ssq, row, fq, 16, invk);
            _Pragma("unroll") for (int bj = 0; bj < 2; ++bj) { f32x4 v0 = acc[ai][bj][m][0] * r, v1 = acc[ai][bj][m][1] * r;
                _Pragma("unroll") for (int e = 0; e < 4; ++e) { v0[e] = sigm(v0[e]); v1[e] = sigm(v1[e]); }
                st16(O + (unsigned)row * 1024 + bj * 128 + cw, pack8(v0, v1)); }
        )
    }
};
struct EpiQ { static constexpr bool PERM = true, AFTER_DRAIN = false;
    const float* ssqq; bf16_t *QN, *QR; const float *cosT, *sinT;
    __device__ __forceinline__ void operator()(AccRef acc, const Unit& u, int wr, int wc, int fr, int fq) const {
        const int pn = u.pn;
        EPI_ROWS(
            const float r = rstd_of(ssqq, row, fq, 8, 1.f / 512.f);
            if (pn < 4) {
                _Pragma("unroll") for (int bj = 0; bj < 2; ++bj) st16(QN + (unsigned)row * 1024 + pn * 256 + bj * 128 + wc * 32 + 8 * fq, pack8(acc[ai][bj][m][0] * r, acc[ai][bj][m][1] * r));
            } else {
                const int j0 = 16 * (wc & 1) + 4 * fq; const f32x4 cs = *(const f32x4*)(cosT + (unsigned)row * 32u + j0), sn = *(const f32x4*)(sinT + (unsigned)row * 32u + j0);
                _Pragma("unroll") for (int bj = 0; bj < 2; ++bj) { const int h = (pn - 4) * 4 + 2 * bj + (wc >> 1); bf16_t* dq = QR + (unsigned)row * 512 + h * 64;
                    rope_store2v(dq, acc[ai][bj][m][0] * r, cs[0], cs[1], sn[0], sn[1], j0); rope_store2v(dq, acc[ai][bj][m][1] * r, cs[2], cs[3], sn[2], sn[3], j0 + 2); }
            }
        )
    }
};
struct EpiKV { static constexpr bool PERM = true, AFTER_DRAIN = false;
    const float* ssqkv; bf16_t *KN, *VT;
    __device__ __forceinline__ void operator()(AccRef acc, const Unit& u, int wr, int wc, int fr, int fq) const {
        const int h = u.pn, cw = wc * 32 + 8 * fq;
        EPI_ROWS(
            const float r = rstd_of(ssqkv, row, fq, 4, 1.f / 256.f);
            st16(KN + (unsigned)row * 1024 + h * 128 + cw, pack8(acc[ai][0][m][0] * r, acc[ai][0][m][1] * r));
            const int odd = fr & 1;
            const unsigned voff2 = (unsigned)((((row >> 13) * 8 + h) * 128 + cw + odd) * SEQ + ((row & 8191) & ~1));
            _Pragma("unroll") for (int n = 0; n < 2; ++n) { const u32x2 w = pack4(acc[ai][1][m][n] * r);
                const unsigned px = (unsigned)__builtin_amdgcn_update_dpp(0, (int)w.x, 0xB1, 0xF, 0xF, true), py = (unsigned)__builtin_amdgcn_update_dpp(0, (int)w.y, 0xB1, 0xF, 0xF, true);
                const unsigned ox = odd ? ((px >> 16) | (w.x & 0xffff0000u)) : ((w.x & 0xffffu) | (px << 16));
                const unsigned oy = odd ? ((py >> 16) | (w.y & 0xffff0000u)) : ((w.y & 0xffffu) | (py << 16));
                const unsigned vo = voff2 + (unsigned)(4 * n) * SEQ;
                st4(VT + vo, ox); st4(VT + vo + 2u * SEQ, oy); }
        )
    }
};
template <bool ADD> struct EpiMulAdd { static constexpr bool PERM = true, AFTER_DRAIN = false;
    const bf16_t* mul; const bf16_t* add; bf16_t* O;
    __device__ __forceinline__ void operator()(AccRef acc, const Unit& u, int wr, int wc, int fr, int fq) const {
        const int cw = u.pn * 256 + wc * 32 + 8 * fq;
        EPI_ROWS(
            _Pragma("unroll") for (int bj = 0; bj < 2; ++bj) { const unsigned off = (unsigned)row * 1024u + (unsigned)(bj * 128 + cw);
                const u32x4 g = *(const u32x4*)(mul + off); f32x4 v0 = acc[ai][bj][m][0] * unlo(g), v1 = acc[ai][bj][m][1] * unhi(g);
                if (ADD) { const u32x4 a = *(const u32x4*)(add + off); v0 += unlo(a); v1 += unhi(a); }
                st16(O + off, pack8(v0, v1)); }
        )
    }
};
template <bool MUL> struct EpiRes { static constexpr bool PERM = true, AFTER_DRAIN = false;
    const float* xin; float* xout; bf16_t* xb; float* ssq; const bf16_t* mul;
    __device__ __forceinline__ void operator()(AccRef acc, const Unit& u, int wr, int wc, int fr, int fq) const {
        const int cw = u.pn * 256 + wc * 32 + 8 * fq;
        EPI_ROWS(
            float s = 0.f;
            _Pragma("unroll") for (int bj = 0; bj < 2; ++bj) { const unsigned off = (unsigned)row * 1024u + (unsigned)(bj * 128 + cw);
                f32x4 v0 = acc[ai][bj][m][0], v1 = acc[ai][bj][m][1];
                if (MUL) { const u32x4 g = *(const u32x4*)(mul + off); v0 *= unlo(g); v1 *= unhi(g); }
                v0 += *(const f32x4*)(xin + off); v1 += *(const f32x4*)(xin + off + 4);
                st16f(xout + off, v0); st16f(xout + off + 4, v1); st16(xb + off, pack8(v0, v1)); s += sq4(v0) + sq4(v1); }
            s = quad_reduce(s); if (fq == 0) st4f(ssq + (unsigned)row * 16u + (unsigned)(u.pn * 4 + wc), s);
        )
    }
};
struct EpiGU { static constexpr bool PERM = true, AFTER_DRAIN = false;
    const float* ssq; bf16_t* H;
    __device__ __forceinline__ void operator()(AccRef acc, const Unit& u, int wr, int wc, int fr, int fq) const {
        const int cw = u.pn * 128 + wc * 32 + 8 * fq;
        EPI_ROWS(
            const float r = rstd_of(ssq, row, fq, 16, 1.f / 1024.f);
            f32x4 g0 = acc[ai][0][m][0] * r, g1 = acc[ai][0][m][1] * r; const f32x4 u0 = acc[ai][1][m][0] * r, u1 = acc[ai][1][m][1] * r;
            _Pragma("unroll") for (int e = 0; e < 4; ++e) { g0[e] = g0[e] * sigm(g0[e]) * u0[e]; g1[e] = g1[e] * sigm(g1[e]) * u1[e]; }
            st16(H + (unsigned)row * DFF + cw, pack8(g0, g1));
        )
    }
};

template <class Epi> __device__ __forceinline__ void run_gemm(LAS unsigned char* lds, const bf16_t* A, const bf16_t* Bt, int N, int K, int cid, const Epi& E) {
    asm volatile("" : "+s"(K), "+s"(N));
    pg8::Gemm g{A, Bt, M, N, K}; pg8::StaticOrder S; S.init(M, N, (int)gridDim.x, cid);
    pg8::gemm_phase<Epi, pg8::StaticOrder, true, true>(lds, g, S, E);
}

enum { MAP_ID = 0, MAP_IN = 1, MAP_Q = 2, MAP_GATE = 3, MAP_UP = 4 };
__device__ __forceinline__ int maprow(int map, int n) {
    switch (map) {
        case MAP_IN: if (n < 1280) return n; else { const int j = (n - 1280) & 31, s = (n - 1280) >> 5; return 1280 + 2 * j + s; }
        case MAP_Q: { const int h = n / 192, d = n % 192; if (d < 128) return h * 128 + d; const int j = (d - 128) & 31, s = (d - 128) >> 5; return 1024 + h * 64 + 2 * j + s; }
        case MAP_GATE: return (n >> 7) * 256 + (n & 127);
        case MAP_UP: return (n >> 7) * 256 + 128 + (n & 127);
        default: return n;
    }
}
__device__ __forceinline__ void cvt_item(const float* W, int ld, int ncol0, int N, int K, bf16_t* WT, const float* gain, float cs, int map, int item, LAS float* scr, int lane) {
    const int nblk = N / 32, kb = item / nblk, nb = item % nblk, k0 = 64 * kb, n0 = 32 * nb;
#pragma unroll
    for (int i = 0; i < 32; ++i) { const int kk = 2 * i + (lane >> 5); scr[kk * 33 + (lane & 31)] = __builtin_nontemporal_load(W + (size_t)(k0 + kk) * ld + ncol0 + n0 + (lane & 31)); }
    const int c = lane & 7;
    f32x4 g0 = (f32x4){cs, cs, cs, cs}, g1 = g0;
    if (gain) { g0 = *(const f32x4*)(gain + k0 + 8 * c) * cs; g1 = *(const f32x4*)(gain + k0 + 8 * c + 4) * cs; }
    asm volatile("s_waitcnt lgkmcnt(0)" ::: "memory");
#pragma unroll
    for (int j = 0; j < 4; ++j) { const int n = (lane >> 3) + 8 * j; const LAS float* sp = scr + (8 * c) * 33 + n;
        u32x4 o; o.x = pk(sp[0 * 33] * g0[0], sp[1 * 33] * g0[1]); o.y = pk(sp[2 * 33] * g0[2], sp[3 * 33] * g0[3]); o.z = pk(sp[4 * 33] * g1[0], sp[5 * 33] * g1[1]); o.w = pk(sp[6 * 33] * g1[2], sp[7 * 33] * g1[3]);
        st16(WT + (size_t)maprow(map, n0 + n) * K + k0 + 8 * c, o); }
    asm volatile("s_waitcnt lgkmcnt(0)" ::: "memory");
}

struct Args { const float* in[22]; float* out; unsigned char* ws; double invfreq[32]; };

__device__ __forceinline__ void weights_phase(const Args& a, int l_, LAS unsigned char* lds) {
    int l = l_; asm volatile("" : "+s"(l));
    int tid_ = threadIdx.x; asm volatile("" : "+v"(tid_)); const int tid = tid_, lane = tid & 63, wave = tid >> 6;
    LAS float* scr = (LAS float*)(lds + wave * 16384);
    const int gw = blockIdx.x * 8 + wave, NGW = gridDim.x * 8;
    unsigned char* ws = fresh(a.ws);
    const float* w_in = a.in[4] + (size_t)l * DM * INW; const float* norm_mix = a.in[3] + l * DM;
    const float* w_uq = a.in[9] + (size_t)l * 512 * 1536; const float* q_norm = a.in[7] + l * 512;
    const float* w_ukv = a.in[10] + (size_t)l * 256 * 2048; const float* kv_norm = a.in[8] + l * 256;
    const float* w_b = a.in[12] + (size_t)l * DM * DM; const float* w_o = a.in[13] + (size_t)l * DM * DM;
    const float* norm_ffn = a.in[14] + l * DM; const float* w_gate = a.in[15] + (size_t)l * DM * DFF; const float* w_up = a.in[16] + (size_t)l * DM * DFF;
    const float* w_down = a.in[17] + (size_t)l * DFF * DM; const float* norm_ple = a.in[18] + l * DM; const float* w_pg = a.in[19] + (size_t)l * DM * DM;
    const float* w_ple = a.in[20] + (size_t)l * PLE * DM;
    const float C2 = 0.07216878364870322f * 1.4426950408889634f;
    constexpr int I0 = 16 * 42, I1 = 16 * 64, I2 = 8 * 48, I3 = 4 * 64, I4 = 16 * 32, I5 = 16 * 32, I6 = 16 * 88, I7 = 16 * 88, I8 = 44 * 32, I9 = 16 * 32, I10 = 4 * 32;
    constexpr int NIT = I0 + I1 + I2 + I3 + I4 + I5 + I6 + I7 + I8 + I9 + I10;
    for (int it = gw; it < NIT; it += NGW) {
        int r = it;
        if (r < I0) { cvt_item(w_in, INW, 0, 1344, DM, (bf16_t*)(ws + W_IN), norm_mix, 1.f, MAP_IN, r, scr, lane); continue; } r -= I0;
        if (r < I1) { cvt_item(w_in, INW, 1344, 2048, DM, (bf16_t*)(ws + W_G), norm_mix, 1.f, MAP_ID, r, scr, lane); continue; } r -= I1;
        if (r < I2) { cvt_item(w_uq, 1536, 0, 1536, 512, (bf16_t*)(ws + W_UQ), q_norm, C2, MAP_Q, r, scr, lane); continue; } r -= I2;
        if (r < I3) { cvt_item(w_ukv, 2048, 0, 2048, 256, (bf16_t*)(ws + W_UKV), kv_norm, 1.f, MAP_ID, r, scr, lane); continue; } r -= I3;
        if (r < I4) { cvt_item(w_b, DM, 0, DM, DM, (bf16_t*)(ws + W_B), nullptr, 1.f, MAP_ID, r, scr, lane); continue; } r -= I4;
        if (r < I5) { cvt_item(w_o, DM, 0, DM, DM, (bf16_t*)(ws + W_O), nullptr, 1.f, MAP_ID, r, scr, lane); continue; } r -= I5;
        if (r < I6) { cvt_item(w_gate, DFF, 0, DFF, DM, (bf16_t*)(ws + W_GU), norm_ffn, 1.f, MAP_GATE, r, scr, lane); continue; } r -= I6;
        if (r < I7) { cvt_item(w_up, DFF, 0, DFF, DM, (bf16_t*)(ws + W_GU), norm_ffn, 1.f, MAP_UP, r, scr, lane); continue; } r -= I7;
        if (r < I8) { cvt_item(w_down, DM, 0, DM, DFF, (bf16_t*)(ws + W_D), nullptr, 1.f, MAP_ID, r, scr, lane); continue; } r -= I8;
        if (r < I9) { cvt_item(w_pg, DM, 0, DM, DM, (bf16_t*)(ws + W_PG), norm_ple, 1.f, MAP_ID, r, scr, lane); continue; } r -= I9;
        cvt_item(w_ple, DM, 0, DM, PLE, (bf16_t*)(ws + W_PLE), nullptr, 1.f, MAP_ID, r, scr, lane);
    }
    const int gt = blockIdx.x * NTHREADS + tid, NGT = gridDim.x * NTHREADS;
    {
        const float* w_pool = a.in[5] + (size_t)l * 4 * 128 * 128; const float* pscale = a.in[6] + l * 512; const float* w_a = a.in[11] + (size_t)l * 512 * DM;
        bf16_t* WA = (bf16_t*)(ws + W_A);
        for (int it = gt; it < 1024 * 64; it += NGT) {
            const int n = it & 1023, cb = it >> 10, g = cb >> 4, c0 = (cb & 15) * 8;
            float accv[8];
#pragma unroll
            for (int i = 0; i < 8; ++i) accv[i] = 0.f;
            const float* wp = w_pool + ((size_t)g * 128 + c0) * 128;
#pragma unroll 4
            for (int d = 0; d < 128; d += 4) {
                const f32x4 psv = *(const f32x4*)(pscale + g * 128 + d);
                const float t0 = psv[0] * w_a[(size_t)(g * 128 + d) * DM + n], t1 = psv[1] * w_a[(size_t)(g * 128 + d + 1) * DM + n], t2 = psv[2] * w_a[(size_t)(g * 128 + d + 2) * DM + n], t3 = psv[3] * w_a[(size_t)(g * 128 + d + 3) * DM + n];
#pragma unroll
                for (int i = 0; i < 8; ++i) { const f32x4 wv4 = *(const f32x4*)(wp + i * 128 + d); accv[i] += (wv4[0] * t0 + wv4[1] * t1) + (wv4[2] * t2 + wv4[3] * t3); } }
            u32x4 o; o.x = pk(accv[0], accv[1]); o.y = pk(accv[2], accv[3]); o.z = pk(accv[4], accv[5]); o.w = pk(accv[6], accv[7]);
            st16(WA + (size_t)n * 512 + g * 128 + c0, o);
        }
    }
    {
        const float* p = a.in[1] + (size_t)l * M * PLE; bf16_t* PB = (bf16_t*)(ws + WS_PB);
        for (int i = gt; i < M * PLE / 8; i += NGT) { const f32x4 v0 = __builtin_nontemporal_load((const f32x4*)(p + (size_t)i * 8)), v1 = __builtin_nontemporal_load((const f32x4*)(p + (size_t)i * 8 + 4)); st16(PB + (size_t)i * 8, pack8(v0, v1)); }
    }
}

__device__ __forceinline__ void prologue_phase(const Args& a) {
    int tid_ = threadIdx.x; asm volatile("" : "+v"(tid_)); const int tid = tid_, lane = tid & 63, wave = tid >> 6;
    const int gw = blockIdx.x * 8 + wave, NGW = gridDim.x * 8, gt = blockIdx.x * NTHREADS + tid, NGT = gridDim.x * NTHREADS;
    unsigned char* ws = fresh(a.ws);
    float* ssq = (float*)(ws + WS_SSQ) + (size_t)ST_X * M * 16;
    for (int i = gt; i < 192 * DM / 8; i += NGT) st16((bf16_t*)(ws + W_IN) + (size_t)1344 * DM + (size_t)i * 8, (u32x4){0u, 0u, 0u, 0u});
    const float* x = a.in[0]; bf16_t* XB = (bf16_t*)(ws + A_XB0);
    for (int r = gw; r < M; r += NGW) {
        const f32x4* xr = (const f32x4*)(x + (size_t)r * DM) + lane; float s = 0.f; f32x4 v[4];
#pragma unroll
        for (int j = 0; j < 4; ++j) { v[j] = __builtin_nontemporal_load(xr + 64 * j); s += sq4(v[j]); }
#pragma unroll
        for (int o = 1; o < 64; o <<= 1) s += __shfl_xor(s, o);
        u32x2* o8 = (u32x2*)(XB + (size_t)r * DM) + lane;
#pragma unroll
        for (int j = 0; j < 4; ++j) { u32x2 w; w.x = pk(v[j][0], v[j][1]); w.y = pk(v[j][2], v[j][3]); st8(o8 + 64 * j, w); }
        if (lane < 16) st4f(ssq + (size_t)r * 16 + lane, (lane == 0) ? s : 0.f);
    }
    const int* pos = (const int*)a.in[2]; float* cosT = (float*)(ws + WS_COS); float* sinT = (float*)(ws + WS_SIN);
    for (int i = gt; i < M * 32; i += NGT) {
        const int r = i >> 5, j = i & 31; const double ang = (double)pos[r] * a.invfreq[j];
        const double k = rint(ang * 0.15915494309189535); double t = fma(-k, 6.283185307179586, ang); t = fma(-k, 2.4492935982947064e-16, t);
        const double t2 = t * t; double c = 1.0, s = t, tc = 1.0, ts = t;
#pragma unroll
        for (int q = 1; q <= 14; ++q) { tc *= -t2 * (1.0 / ((2.0 * q - 1.0) * (2.0 * q))); c += tc; ts *= -t2 * (1.0 / ((2.0 * q) * (2.0 * q + 1.0))); s += ts; }
        st4f(cosT + i, (float)c); st4f(sinT + i, (float)s);
    }
}

__device__ __forceinline__ void pool_phase(const bf16_t* U, bf16_t* P) {
    int tid_ = threadIdx.x; asm volatile("" : "+v"(tid_)); const int gt = blockIdx.x * NTHREADS + tid_, NGT = gridDim.x * NTHREADS;
    for (int it = gt; it < M * 64; it += NGT) {
        const int row = it >> 6, ch = it & 63, g = ch >> 4, w = 2 << g, tl = row & (SEQ - 1), n = (tl + 1 < w) ? tl + 1 : w;
        const bf16_t* src = U + (size_t)row * 512 + ch * 8;
        const u32x4 own = ld16c(src); f32x4 s0 = unlo(own), s1 = unhi(own); const f32x4 o0 = s0, o1 = s1;
        u32x4 wv[15];
#pragma unroll
        for (int j = 1; j < 16; ++j) wv[j - 1] = (j < n) ? ld16c(src - (size_t)j * 512) : (u32x4){0u, 0u, 0u, 0u};
#pragma unroll
        for (int j = 1; j < 16; ++j) { s0 += unlo(wv[j - 1]); s1 += unhi(wv[j - 1]); }
        const float inv = 1.f / (float)n;
        st16(P + (size_t)row * 512 + ch * 8, pack8(s0 * inv - o0, s1 * inv - o1));
    }
}
__device__ __forceinline__ void final_phase(float* X, const float* ssq, const float* gn) {
    int tid_ = threadIdx.x; asm volatile("" : "+v"(tid_)); const int lane = tid_ & 63, wave = tid_ >> 6;
    const int gw = blockIdx.x * 8 + wave, NGW = gridDim.x * 8;
    f32x4 g[4];
#pragma unroll
    for (int j = 0; j < 4; ++j) g[j] = *(const f32x4*)(gn + 4 * lane + 256 * j);
    for (int r = gw; r < M; r += NGW) {
        float t = (lane < 16) ? ssq[(size_t)r * 16 + lane] : 0.f;
        t += __shfl_xor(t, 1); t += __shfl_xor(t, 2); t += __shfl_xor(t, 4); t += __shfl_xor(t, 8);
        t = __shfl(t, 0);
        const float rs = rsqrtf(t * (1.f / 1024.f) + EPS);
        f32x4* xr = (f32x4*)(X + (size_t)r * DM) + lane;
        f32x4 v[4];
#pragma unroll
        for (int j = 0; j < 4; ++j) v[j] = __builtin_nontemporal_load(xr + 64 * j);
#pragma unroll
        for (int j = 0; j < 4; ++j) __builtin_nontemporal_store(v[j] * rs * g[j], xr + 64 * j);
    }
}

constexpr int KROW = 400, VROW = 144, KBUF = 64 * KROW, VBUF = 128 * VROW, VBASE = 2 * KBUF;
__device__ __forceinline__ float max3f(float a, float b, float c) { float r; asm("v_max3_f32 %0, %1, %2, %3" : "=v"(r) : "v"(a), "v"(b), "v"(c)); return r; }
__device__ __forceinline__ void attn_unit(LAS unsigned char* lds, int b, int h, int qb, const bf16_t* QN, const bf16_t* QR, const bf16_t* KN, const bf16_t* KPE, const bf16_t* VT, bf16_t* O) {
    int tid_ = threadIdx.x; asm volatile("" : "+v"(tid_)); const int tid = tid_, lane = tid & 63, wid = __builtin_amdgcn_readfirstlane(tid >> 6), q = lane & 31, hi = lane >> 5;
    const bool grpB = wid >= 4;
    const size_t rowbase = (size_t)b * SEQ; const int q0 = qb * 256, qrow = q0 + wid * 32 + q;
    f32x16 o[4];
#pragma unroll
    for (int i = 0; i < 4; ++i) o[i] = (f32x16){};
    float mrun = 0.f, lrun = 0.f;
    f32x16 negm = (f32x16){};
    const int NT = 4 * (qb + 1);
    const int kk0 = tid >> 4, kc0 = tid & 15;
    const bf16_t* ksrc = KN + (rowbase + kk0) * 1024 + h * 128 + kc0 * 8;
    const int kdst = kk0 * KROW + kc0 * 16;
    const int rk = tid >> 3, rc = tid & 7;
    const bf16_t* rsrc = KPE + (rowbase + rk) * 64 + rc * 8;
    const int rdst = rk * KROW + 256 + rc * 16;
    const int vd0 = tid >> 3, vc0 = tid & 7;
    const bf16_t* vsrc = VT + ((size_t)(b * 8 + h) * 128 + vd0) * SEQ + vc0 * 8;
    const int vdst = VBASE + vd0 * VROW + vc0 * 16;
    u32x4 sk0, sk1, sr, sv0, sv1;
#define ATT_LOAD(t) do { sk0 = ld16c(ksrc + (size_t)(t) * 64 * 1024); sk1 = ld16c(ksrc + (size_t)(t) * 64 * 1024 + 32 * 1024); sr = ld16c(rsrc + (size_t)(t) * 64 * 64); \
        sv0 = ld16c(vsrc + (t) * 64); sv1 = ld16c(vsrc + (size_t)64 * SEQ + (t) * 64); } while (0)
#define ATT_STORE(kb, vb) do { LAS unsigned char* bk = lds + (kb) * KBUF; LAS unsigned char* bv = lds + (vb) * VBUF; *(LAS u32x4*)(bk + kdst) = sk0; *(LAS u32x4*)(bk + kdst + 32 * KROW) = sk1; *(LAS u32x4*)(bk + rdst) = sr; \
        *(LAS u32x4*)(bv + vdst) = sv0; *(LAS u32x4*)(bv + vdst + 64 * VROW) = sv1; } while (0)
#define ATT_PV(vb) do { const LAS unsigned char* bv = lds + VBASE + (vb) * VBUF + vfrag; __builtin_amdgcn_s_setprio(1); \
        _Pragma("unroll") for (int ks = 0; ks < 4; ++ks) { const bf16x8 pb = __builtin_bit_cast(bf16x8, pw[ks]); \
            _Pragma("unroll") for (int db = 0; db < 4; ++db) { const bf16x8 vf = *(const LAS bf16x8*)(bv + db * 32 * VROW + ks * 32); o[db] = __builtin_amdgcn_mfma_f32_32x32x16_bf16(vf, pb, o[db], 0, 0, 0); } } __builtin_amdgcn_s_setprio(0); } while (0)
    const int pr = (q & ~12) | ((q & 4) << 1) | ((q & 8) >> 1);
    const int kfrag = pr * KROW + 16 * hi, vfrag = q * VROW + 16 * hi;
    u32x4 pw[4]; bool pend = false;
    int vb_prev = 0, vb_cur = 0, vb_next = 1;
    ATT_LOAD(0);
    bf16x8 qf[12];
    { const bf16_t* qnp = QN + (rowbase + qrow) * 1024 + h * 128 + 8 * hi; const bf16_t* qrp = QR + (rowbase + qrow) * 512 + h * 64 + 8 * hi;
#pragma unroll
      for (int d0 = 0; d0 < 8; ++d0) qf[d0] = __builtin_bit_cast(bf16x8, ld16c(qnp + 16 * d0));
#pragma unroll
      for (int d0 = 0; d0 < 4; ++d0) qf[8 + d0] = __builtin_bit_cast(bf16x8, ld16c(qrp + 16 * d0)); }
    ATT_STORE(0, 0); ATT_LOAD(1); __syncthreads();
#pragma unroll
    for (int i = 0; i < 12; ++i) asm volatile("" :: "v"(qf[i]));
    for (int t = 0; t < NT; ++t) {
        bool staged = false;
        if (pend) { ATT_PV(vb_prev); pend = false; }
        const int kv0 = 64 * t;
        if (kv0 <= q0 + wid * 32 + 31) {
            const LAS unsigned char* bb = lds + (t & 1) * KBUF;
            f32x16 p0 = negm, p1 = negm;
            __builtin_amdgcn_s_setprio(1);
#pragma unroll
            for (int d0 = 0; d0 < 12; ++d0) {
                const bf16x8 a0 = *(const LAS bf16x8*)(bb + kfrag + d0 * 32), a1 = *(const LAS bf16x8*)(bb + kfrag + 32 * KROW + d0 * 32);
                p0 = __builtin_amdgcn_mfma_f32_32x32x16_bf16(a0, qf[d0], p0, 0, 0, 0); p1 = __builtin_amdgcn_mfma_f32_32x32x16_bf16(a1, qf[d0], p1, 0, 0, 0);
            }
            __builtin_amdgcn_s_setprio(0);
            if (kv0 + 63 > q0 + wid * 32) {
#pragma unroll
                for (int r = 0; r < 16; ++r) { const int kv = kv0 + 16 * (r >> 3) + 8 * hi + (r & 7); if (kv > qrow) p0[r] = -1e30f; if (kv + 32 > qrow) p1[r] = -1e30f; }
            }
            float mt = fmaxf(p0[0], p1[0]);
#pragma unroll
            for (int r = 1; r < 16; ++r) mt = fmaxf(mt, fmaxf(p0[r], p1[r]));
            mt = fmaxf(mt, __shfl_xor(mt, 32));
            if (t == 0 || __any(mt > 8.f)) {
                const float dl = (t == 0) ? mt : fmaxf(mt, 0.f), alpha = __builtin_amdgcn_exp2f(-dl); mrun += dl; lrun *= alpha;
#pragma unroll
                for (int r = 0; r < 16; ++r) { p0[r] -= dl; p1[r] -= dl; }
#pragma unroll
                for (int i = 0; i < 4; ++i) o[i] *= alpha;
#pragma unroll
                for (int r = 0; r < 16; ++r) negm[r] = -mrun;
            }
            float ls = 0.f;
#pragma unroll
            for (int r = 0; r < 16; ++r) { p0[r] = __builtin_amdgcn_exp2f(p0[r]); p1[r] = __builtin_amdgcn_exp2f(p1[r]); ls += p0[r] + p1[r]; }
            lrun += ls;
            pw[0] = (u32x4){pk(p0[0], p0[1]), pk(p0[2], p0[3]), pk(p0[4], p0[5]), pk(p0[6], p0[7])};
            pw[1] = (u32x4){pk(p0[8], p0[9]), pk(p0[10], p0[11]), pk(p0[12], p0[13]), pk(p0[14], p0[15])};
            pw[2] = (u32x4){pk(p1[0], p1[1]), pk(p1[2], p1[3]), pk(p1[4], p1[5]), pk(p1[6], p1[7])};
            pw[3] = (u32x4){pk(p1[8], p1[9]), pk(p1[10], p1[11]), pk(p1[12], p1[13]), pk(p1[14], p1[15])};
            if (grpB) pend = true; else { if (t + 1 < NT) { ATT_STORE((t + 1) & 1, vb_next); staged = true; if (t + 2 < NT) ATT_LOAD(t + 2); } ATT_PV(vb_cur); }
        }
        if (t + 1 < NT && !staged) { ATT_STORE((t + 1) & 1, vb_next); if (t + 2 < NT) ATT_LOAD(t + 2); }
        vb_prev = vb_cur; vb_cur = vb_next; vb_next = (vb_next == 2) ? 0 : vb_next + 1;
        __syncthreads();
    }
    if (pend) ATT_PV(vb_prev);
#undef ATT_LOAD
#undef ATT_STORE
#undef ATT_PV
    const float l = lrun + __shfl_xor(lrun, 32), inv = 1.f / l;
    bf16_t* op = O + (rowbase + qrow) * 1024 + h * 128 + 4 * hi;
#pragma unroll
    for (int db = 0; db < 4; ++db)
#pragma unroll
        for (int g = 0; g < 4; ++g) { u32x2 w; w.x = pk(o[db][4 * g] * inv, o[db][4 * g + 1] * inv); w.y = pk(o[db][4 * g + 2] * inv, o[db][4 * g + 3] * inv); st8(op + 32 * db + 8 * g, w); }
    __syncthreads();
}
__device__ __forceinline__ void attn_phase(LAS unsigned char* lds, const bf16_t* QN, const bf16_t* QR, const bf16_t* KN, const bf16_t* KPE, const bf16_t* VT, bf16_t* O) {
    for (int pi = blockIdx.x; pi < 256; pi += gridDim.x) {
        const int bh = pi >> 4, s = pi & 15;
        attn_unit(lds, bh >> 3, bh & 7, 31 - s, QN, QR, KN, KPE, VT, O);
        attn_unit(lds, bh >> 3, bh & 7, s, QN, QR, KN, KPE, VT, O);
    }
}

#define XB_TMO      128
#define XB_XCNT(j)  (256  + 64 * (j))
#define XB_XSUB(j)  (1280 + 64 * (j))
#define XB_XGEN(j)  (2304 + 64 * (j))
#define XB_TOP      3328
#define XB_TOPGEN   3392
#define XCD_BAR_WORDS 3456
#define XB_SPIN_CAP (1u << 18)

__device__ __forceinline__ unsigned xb_ld(unsigned* p)              { return __hip_atomic_load(p, __ATOMIC_RELAXED, __HIP_MEMORY_SCOPE_AGENT); }
__device__ __forceinline__ unsigned xb_add(unsigned* p, unsigned v) { return __hip_atomic_fetch_add(p, v, __ATOMIC_RELAXED, __HIP_MEMORY_SCOPE_AGENT); }
__device__ __forceinline__ unsigned xb_xcc_id() { return (unsigned)__builtin_amdgcn_s_getreg((3 << 11) | 20) & 0xFu; }
#define XB_SPIN(cond, bar) do { unsigned _sp = 0; while (cond) { __builtin_amdgcn_s_sleep(1); \
    if ((++_sp & 255u) == 0u) { if (xb_ld(&(bar)[XB_TMO])) break; if (_sp > XB_SPIN_CAP) { atomicAdd(&(bar)[XB_TMO], 1u); break; } } } } while (0)

struct XcdBarrier {
    unsigned* bar; unsigned x;
    volatile LAS unsigned* st;
};

__device__ __forceinline__ XcdBarrier xcd_barrier_post(unsigned* bar, volatile LAS unsigned* st) {
    XcdBarrier b; b.bar = bar; b.x = xb_xcc_id(); b.st = st;
    if (threadIdx.x == 0) (void)xb_add(&bar[XB_XCNT(b.x)], 1u);
    return b;
}
__device__ __forceinline__ void xcd_barrier_complete(unsigned* bar, unsigned x, unsigned& nloc, unsigned& nx) {
    const unsigned G = gridDim.x * gridDim.y * gridDim.z;
    unsigned sum, cnt, mine, sp = 0u;
    for (;;) {
        sum = 0u; cnt = 0u; mine = 0u;
#pragma unroll
        for (unsigned j = 0; j < 16; ++j) { const unsigned c = xb_ld(&bar[XB_XCNT(j)]); sum += c; cnt += (c > 0u) ? 1u : 0u; mine = (j == x) ? c : mine; }
        if (sum == G) break;
        __builtin_amdgcn_s_sleep(1);
        if ((++sp & 255u) == 0u) { if (xb_ld(&bar[XB_TMO])) break; if (sp > XB_SPIN_CAP) { atomicAdd(&bar[XB_TMO], 1u); break; } }
    }
    nloc = mine > 0u ? mine : 1u; nx = cnt > 0u ? cnt : 1u;
}

__device__ __forceinline__ void xcd_barrier(const XcdBarrier& b) {
    asm volatile("s_waitcnt vmcnt(0)" ::: "memory");
    __syncthreads();
    if (threadIdx.x == 0) {
        unsigned* bar = b.bar;
        __builtin_amdgcn_s_waitcnt(0);
        unsigned nloc = b.st[0], nx = b.st[1];
        if (nloc == 0u) { xcd_barrier_complete(bar, b.x, nloc, nx); b.st[0] = nloc; b.st[1] = nx; }
        const unsigned old = xb_add(&bar[XB_XSUB(b.x)], 1u);
        const unsigned gen = old / nloc;
        if (old + 1u == (gen + 1u) * nloc) {
            __builtin_amdgcn_fence(__ATOMIC_RELEASE, "agent");
            asm volatile("s_waitcnt vmcnt(0)" ::: "memory");
            const unsigned og = xb_add(&bar[XB_TOP], 1u);
            const unsigned tg = og / nx;
            if (og + 1u == (tg + 1u) * nx) xb_add(&bar[XB_TOPGEN], 1u);
            else XB_SPIN(xb_ld(&bar[XB_TOPGEN]) == tg, bar);
            __builtin_amdgcn_fence(__ATOMIC_ACQUIRE, "agent");
            xb_add(&bar[XB_XGEN(b.x)], 1u);
            asm volatile("s_waitcnt vmcnt(0)" ::: "memory");
        } else {
            XB_SPIN(xb_ld(&bar[XB_XGEN(b.x)]) == gen, bar);
            __builtin_amdgcn_fence(__ATOMIC_ACQUIRE, "agent");
            asm volatile("s_waitcnt vmcnt(0)" ::: "memory");
        }
    }
    __syncthreads();
}

#ifdef DBG_STOP
__device__ __forceinline__ float bfval(const bf16_t* p, size_t i) { return __uint_as_float((unsigned)p[i] << 16); }
__device__ __forceinline__ void dbg_dump(unsigned char* ws, float* out, int k) {
    const size_t gt = (size_t)blockIdx.x * NTHREADS + threadIdx.x, NGT = (size_t)gridDim.x * NTHREADS;
    for (size_t i = gt; i < (size_t)M * 1024; i += NGT) { const size_t row = i >> 10, c = i & 1023; float v = 0.f;
        if (k == 1) v = bfval((bf16_t*)(ws + A_U), row * 512 + (c & 511)) + 2.f * bfval((bf16_t*)(ws + A_CQ), row * 512 + (c & 511)) + 4.f * bfval((bf16_t*)(ws + A_CKV), row * 256 + (c & 255)) + 8.f * bfval((bf16_t*)(ws + A_KPE), row * 64 + (c & 63));
        if (k == 2) v = bfval((bf16_t*)(ws + A_POOL), row * 512 + (c & 511)) + 2.f * bfval((bf16_t*)(ws + A_QN), i) + 4.f * bfval((bf16_t*)(ws + A_QR), row * 512 + (c & 511)) + 8.f * bfval((bf16_t*)(ws + A_KN), i) + 16.f * bfval((bf16_t*)(ws + A_VT), i);
        if (k == 3) v = bfval((bf16_t*)(ws + A_QN), i);
        if (k == 4) v = bfval((bf16_t*)(ws + A_SGA), i) + 2.f * bfval((bf16_t*)(ws + A_SGB), i);
        if (k == 6) v = bfval((bf16_t*)(ws + A_HMID), row * DFF + c) + 2.f * bfval((bf16_t*)(ws + A_HMID), row * DFF + 1024 + c) + 4.f * bfval((bf16_t*)(ws + A_HMID), row * DFF + 1792 + c);
        st4f(out + i, v); }
}
#ifndef DBG_LAYER
#define DBG_LAYER 0
#endif
#define DBG(k) do { if (DBG_STOP == (k) && l == DBG_LAYER) { if ((k) != 5 && (k) != 7 && (k) != 8) dbg_dump(a.ws, a.out, (k)); return; } } while (0)
#else
#define DBG(k) do {} while (0)
#endif
#define BP(off) ((bf16_t*)(ws + (off)))
#define CBP(off) ((const bf16_t*)(ws + (off)))
#define SSQP(idx) ((float*)(ws + WS_SSQ) + (size_t)(idx) * M * 16)
#define GSYNC() do { asm volatile("s_waitcnt vmcnt(0) lgkmcnt(0)" ::: "memory"); xcd_barrier(bar); } while (0)
#define GSYNC_CG() do { asm volatile("s_waitcnt vmcnt(0) lgkmcnt(0)" ::: "memory"); grid.sync(); } while (0)
template <int l> __device__ __forceinline__ void layer_body(const Args& a, LAS unsigned char* lds, cg::grid_group& grid, const XcdBarrier& bar) {
#ifndef SK_W
        weights_phase(a, l, lds);
#endif
        GSYNC();
#ifndef SK_P1
        { unsigned char* ws = fresh(a.ws); const int cid = (int)blockIdx.x;
          EpiZ E{SSQP(ST_X), BP(A_U), BP(A_CQ), BP(A_CKV), BP(A_KPE), SSQP(ST_Q), SSQP(ST_KV), (const float*)(ws + WS_COS), (const float*)(ws + WS_SIN)};
          run_gemm(lds, CBP(A_XB0), CBP(W_IN), 1536, 1024, cid, E); }
#endif
        GSYNC();
        DBG(1);
#ifndef SK_P2
        { unsigned char* ws = fresh(a.ws); pool_phase(CBP(A_U), BP(A_POOL)); }
        { unsigned char* ws = fresh(a.ws); const int cid = (int)blockIdx.x;
          EpiQ E{SSQP(ST_Q), BP(A_QN), BP(A_QR), (const float*)(ws + WS_COS), (const float*)(ws + WS_SIN)}; run_gemm(lds, CBP(A_CQ), CBP(W_UQ), 1536, 512, cid, E); }
        { unsigned char* ws = fresh(a.ws); const int G = (int)gridDim.x, cid = ((int)blockIdx.x + G / 2) % G;
          EpiKV E{SSQP(ST_KV), BP(A_KN), BP(A_VT)}; run_gemm(lds, CBP(A_CKV), CBP(W_UKV), 2048, 256, cid, E); }
#endif
        GSYNC();
        DBG(2);
#ifndef SK_ATT
        { unsigned char* ws = fresh(a.ws); attn_phase(lds, CBP(A_QN), CBP(A_QR), CBP(A_KN), CBP(A_KPE), CBP(A_VT), BP(A_QN)); }
#endif
        GSYNC();
        DBG(3);
#ifndef SK_P4
        { unsigned char* ws = fresh(a.ws); EpiGate E{SSQP(ST_X), 1.f / 1024.f, BP(A_SGA)}; run_gemm(lds, CBP(A_XB0), CBP(W_G), 1024, 1024, (int)blockIdx.x, E); }
        { unsigned char* ws = fresh(a.ws); EpiGate E{SSQP(ST_X), 1.f / 1024.f, BP(A_SGB)}; run_gemm(lds, CBP(A_XB0), CBP(W_G) + (size_t)1024 * 1024, 1024, 1024, (int)blockIdx.x, E); }
        { unsigned char* ws = fresh(a.ws); EpiMulAdd<false> E{CBP(A_SGA), nullptr, BP(A_SGA)}; run_gemm(lds, CBP(A_POOL), CBP(W_A), 1024, 512, (int)blockIdx.x, E); }
        { unsigned char* ws = fresh(a.ws); EpiMulAdd<true> E{CBP(A_SGB), CBP(A_SGA), BP(A_SGA)}; run_gemm(lds, CBP(A_QN), CBP(W_B), 1024, 1024, (int)blockIdx.x, E); }
#endif
        GSYNC();
        DBG(4);
#ifndef SK_P5
        { unsigned char* ws = fresh(a.ws); EpiRes<false> E{l == 0 ? a.in[0] : a.out, a.out, BP(A_XB1), SSQP(ST_1), nullptr}; run_gemm(lds, CBP(A_SGA), CBP(W_O), 1024, 1024, (int)blockIdx.x, E); }
#endif
        GSYNC();
        DBG(5);
#ifndef SK_P6
        { unsigned char* ws = fresh(a.ws); EpiGU E{SSQP(ST_1), BP(A_HMID)}; run_gemm(lds, CBP(A_XB1), CBP(W_GU), 2 * DFF, 1024, (int)blockIdx.x, E); }
#endif
        GSYNC();
        DBG(6);
#ifndef SK_P7
        { unsigned char* ws = fresh(a.ws); EpiRes<false> E{a.out, a.out, BP(A_XB2), SSQP(ST_2), nullptr}; run_gemm(lds, CBP(A_HMID), CBP(W_D), 1024, DFF, (int)blockIdx.x, E); }
#endif
        GSYNC();
        DBG(7);
#ifndef SK_P8
        { unsigned char* ws = fresh(a.ws); EpiGate E{SSQP(ST_2), 1.f / 1024.f, BP(A_G)}; run_gemm(lds, CBP(A_XB2), CBP(W_PG), 1024, 1024, (int)blockIdx.x, E); }
        { unsigned char* ws = fresh(a.ws); EpiRes<true> E{a.out, a.out, BP(A_XB0), SSQP(ST_X), CBP(A_G)}; run_gemm(lds, CBP(WS_PB), CBP(W_PLE), 1024, 256, (int)blockIdx.x, E); }
#endif
        GSYNC();
        DBG(8);
    }
__global__ void __launch_bounds__(NTHREADS) fwd_kernel(Args a) {
    extern __shared__ __attribute__((aligned(16))) unsigned char lds_raw[];
    LAS unsigned char* lds = (LAS unsigned char*)lds_raw;
    cg::grid_group grid = cg::this_grid();
    volatile LAS unsigned* bst = (volatile LAS unsigned*)(lds + 131072);
    if (threadIdx.x < 2) bst[threadIdx.x] = 0u;
    __syncthreads();
    const XcdBarrier bar = xcd_barrier_post((unsigned*)(a.ws + WS_BAR), bst);
    if (a.ws == nullptr) grid.sync();
#ifndef SK_PRO
    prologue_phase(a);
#endif
    layer_body<0>(a, lds, grid, bar);
    layer_body<1>(a, lds, grid, bar);
    { unsigned char* ws = fresh(a.ws); final_phase(a.out, SSQP(ST_X), a.in[21]); }
}

extern "C" void kernel_launch(void* const* d_in, const int* in_sizes, int n_in, void* d_out, int out_size, void* d_ws, size_t ws_size, hipStream_t stream) {
    static int grid_blocks = 0;
    if (grid_blocks == 0) {
        if (n_in != 22 || out_size != M * DM || ws_size < WS_END) { fprintf(stderr, "kernel_launch: unexpected shapes (n_in %d out %d ws %zu)\n", n_in, out_size, ws_size); grid_blocks = -1; return; }
        int dev = 0, cus = 0, per_cu = 0;
        hipGetDevice(&dev); hipDeviceGetAttribute(&cus, hipDeviceAttributeMultiprocessorCount, dev);
        hipFuncSetAttribute((const void*)fwd_kernel, hipFuncAttributeMaxDynamicSharedMemorySize, LDS_BYTES);
        if (hipOccupancyMaxActiveBlocksPerMultiprocessor(&per_cu, (const void*)fwd_kernel, NTHREADS, LDS_BYTES) != hipSuccess || per_cu < 1) per_cu = 1;
        (void)hipGetLastError();
        grid_blocks = cus * per_cu;
    }
    if (grid_blocks < 0) return;
    Args a{};
    for (int i = 0; i < 22; ++i) a.in[i] = (const float*)d_in[i];
    a.out = (float*)d_out; a.ws = (unsigned char*)d_ws;
    for (int j = 0; j < 32; ++j) a.invfreq[j] = pow(10000.0, -(double)j / 32.0);
    if (hipMemsetAsync((char*)d_ws + WS_BAR, 0, WS_BAR_BYTES, stream) != hipSuccess) { fprintf(stderr, "memset failed\n"); return; }
    void* args[] = {&a};
    hipError_t e = hipLaunchCooperativeKernel((const void*)fwd_kernel, dim3(grid_blocks), dim3(NTHREADS), args, LDS_BYTES, stream);
    if (e != hipSuccess) fprintf(stderr, "cooperative launch failed: %s (grid %d)\n", hipGetErrorString(e), grid_blocks);
}
```
